# Optimizing an MI355X kernel written in HIP

```python
import math
import jax, jax.numpy as jnp
from jax import lax
import numpy as np

D_MODEL = 1024
BATCH = 8
SEQ = 4096
DEPTH = 2

CHUNK = 64
SSD_HEADS = 16
SSD_HEAD_DIM = 64
SSD_INNER = SSD_HEADS * SSD_HEAD_DIM
SSD_GROUPS = 2
SSD_STATE = 128
SSD_CONV = 4
SSD_CHUNK = CHUNK
SSD_CONV_DIM = SSD_INNER + 2 * SSD_GROUPS * SSD_STATE
SGU_BLOCK = 128
SGU_GROUPS = 8
SGU_WIDTH = 1024
SGU_GROUP_DIM = SGU_WIDTH // SGU_GROUPS
EVEN_IN = SSD_INNER + SSD_CONV_DIM + SSD_HEADS + 2 * SGU_WIDTH
EVEN_MIX = SSD_INNER + SGU_WIDTH
DIFF_HEADS = 8
DIFF_HEAD_DIM = 64
DIFF_V_DIM = 2 * DIFF_HEAD_DIM
DIFF_QK = DIFF_HEADS * 2 * DIFF_HEAD_DIM
Q_BLOCK = 128
D_FF = 4 * D_MODEL
DEEPNORM_ALPHA = (2 * DEPTH) ** 0.25
DEEPNORM_BETA = (8 * DEPTH) ** -0.25
N_EVEN = (DEPTH + 1) // 2
N_ODD = DEPTH // 2
LN_EPS = 1e-5

kernel_name = 'hybrid_ssd_sgu_diffattn_deepnorm'


def layer_norm(x, g, b):
    xf = x.astype(jnp.float32)
    mu = jnp.mean(xf, axis=-1, keepdims=True)
    var = jnp.mean(jnp.square(xf - mu), axis=-1, keepdims=True)
    y = (xf - mu) * lax.rsqrt(var + LN_EPS) * g.astype(jnp.float32) + b.astype(jnp.float32)
    return y.astype(x.dtype)


def rms_norm(x, w):
    xf = x.astype(jnp.float32)
    y = xf * lax.rsqrt(jnp.mean(jnp.square(xf), axis=-1, keepdims=True) + LN_EPS)
    return (y * w.astype(jnp.float32)).astype(x.dtype)


def causal_dwconv(x, w, b):
    c = x.shape[-1]
    y = lax.conv_general_dilated(x, w[:, None, :].astype(x.dtype), window_strides=(1,),
                                 padding=[(SSD_CONV - 1, 0)],
                                 dimension_numbers=('NWC', 'WIO', 'NWC'),
                                 feature_group_count=c)
    return y + b.astype(x.dtype)


def ssd_chunked_scan(x, dt, a, bm, cm):
    bsz, s, h, p = x.shape
    L = SSD_CHUNK
    nc = s // L
    g = SSD_GROUPS
    hg = h // g
    n = bm.shape[-1]
    xdt = (x * dt[..., None]).reshape(bsz, nc, L, g, hg, p)
    da = (dt * a).reshape(bsz, nc, L, g, hg)
    bm = bm.reshape(bsz, nc, L, g, n)
    cm = cm.reshape(bsz, nc, L, g, n)
    a_cs = jnp.cumsum(da, axis=2)
    causal = jnp.tril(jnp.ones((L, L), dtype=bool))
    seg = a_cs[:, :, :, None] - a_cs[:, :, None, :]
    decay = jnp.exp(jnp.where(causal[None, None, :, :, None, None], seg, -jnp.inf))
    cb = jnp.einsum('bctgn,bcsgn->bctsg', cm, bm)
    y_diag = jnp.einsum('bctsgh,bcsghp->bctghp', cb[..., None] * decay, xdt)
    state_decay = jnp.exp(a_cs[:, :, -1:] - a_cs)
    chunk_states = jnp.einsum('bclgn,bclgh,bclghp->bcghpn', bm, state_decay, xdt)
    chunk_decay = jnp.exp(a_cs[:, :, -1])

    def step(state, inp):
        s_c, d_c = inp
        return d_c[..., None, None] * state + s_c, state

    h0 = jnp.zeros((bsz, g, hg, p, n), jnp.float32)
    _, prev = lax.scan(step, h0, (jnp.moveaxis(chunk_states, 1, 0), jnp.moveaxis(chunk_decay, 1, 0)))
    prev = jnp.moveaxis(prev, 0, 1)
    y_off = jnp.einsum('bctgn,bcghpn,bctgh->bctghp', cm, prev, jnp.exp(a_cs))
    return (y_diag + y_off).reshape(bsz, s, h, p)


def ssd_mixer(z, xbc, dt_raw, conv_w, conv_b, dt_bias, a_log, d_skip, norm_w):
    bsz, s, _ = z.shape
    f32 = jnp.float32
    xbc = jax.nn.silu(causal_dwconv(xbc, conv_w, conv_b))
    xs, bm, cm = jnp.split(xbc, [SSD_INNER, SSD_INNER + SSD_GROUPS * SSD_STATE], axis=-1)
    xs = xs.astype(f32).reshape(bsz, s, SSD_HEADS, SSD_HEAD_DIM)
    bm = bm.astype(f32).reshape(bsz, s, SSD_GROUPS, SSD_STATE)
    cm = cm.astype(f32).reshape(bsz, s, SSD_GROUPS, SSD_STATE)
    dt = jax.nn.softplus(dt_raw.astype(f32) + dt_bias.astype(f32))
    a = -jnp.exp(a_log.astype(f32))
    y = ssd_chunked_scan(xs, dt, a, bm, cm) + xs * d_skip.astype(f32)[:, None]
    y = y.reshape(bsz, s, SSD_INNER) * jax.nn.silu(z.astype(f32))
    yg = y.reshape(bsz, s, SSD_GROUPS, SSD_INNER // SSD_GROUPS)
    yg = yg * lax.rsqrt(jnp.mean(jnp.square(yg), axis=-1, keepdims=True) + LN_EPS)
    y = yg.reshape(bsz, s, SSD_INNER) * norm_w.astype(f32)
    return y.astype(z.dtype)


def sgu_mixer(proj, ln_g, ln_b, w_s, b_s):
    bsz, s, _ = proj.shape
    u, v = jnp.split(jax.nn.gelu(proj, approximate=False), 2, axis=-1)
    v = layer_norm(v, ln_g, ln_b)
    nb = s // SGU_BLOCK
    v = v.reshape(bsz, nb, SGU_BLOCK, SGU_GROUPS, SGU_GROUP_DIM)
    cpos = jnp.arange(SGU_BLOCK) // CHUNK
    mask = cpos[:, None] >= cpos[None, :]
    w = jnp.where(mask[None], w_s, jnp.zeros_like(w_s))
    mixed = jnp.einsum('gts,bnsgc->bntgc', w, v) + b_s.T[None, None, :, :, None]
    return u * mixed.reshape(bsz, s, SGU_WIDTH)


def alibi_slopes(n_heads):
    return jnp.exp2(-8.0 * jnp.arange(1, n_heads + 1, dtype=jnp.float32) / n_heads)


def diff_attention(x, w_qkv, lq1, lk1, lq2, lk2, subln_w, w_out, lambda_init):
    bsz, s, _ = x.shape
    f32 = jnp.float32
    qkv = x @ w_qkv
    q, k, v = jnp.split(qkv, [DIFF_QK, 2 * DIFF_QK], axis=-1)
    q = q.reshape(bsz, s, DIFF_HEADS, 2, DIFF_HEAD_DIM)
    k = k.reshape(bsz, s, DIFF_HEADS, 2, DIFF_HEAD_DIM)
    v = v.reshape(bsz, s, DIFF_HEADS, DIFF_V_DIM)
    lam = (jnp.exp(jnp.sum(lq1.astype(f32) * lk1.astype(f32)))
           - jnp.exp(jnp.sum(lq2.astype(f32) * lk2.astype(f32))) + lambda_init)
    slopes = alibi_slopes(DIFF_HEADS)
    nb = s // Q_BLOCK
    qb = jnp.moveaxis(q.reshape(bsz, nb, Q_BLOCK, DIFF_HEADS, 2, DIFF_HEAD_DIM), 1, 0)
    k_pos = jnp.arange(s)
    scale = DIFF_HEAD_DIM ** -0.5

    def block(args):
        q_i, i = args
        q_pos = i * Q_BLOCK + jnp.arange(Q_BLOCK)
        sc = jnp.einsum('bqhmd,bkhmd->bhmqk', q_i, k, preferred_element_type=f32) * scale
        dist = jnp.abs(q_pos[:, None] - k_pos[None, :]).astype(f32)
        allowed = (k_pos[None, :] // CHUNK) <= (q_pos[:, None] // CHUNK)
        bias = jnp.where(allowed[None], -slopes[:, None, None] * dist[None], -jnp.inf)
        pr = jax.nn.softmax(sc + bias[None, :, None], axis=-1)
        attn = pr[:, :, 0] - lam * pr[:, :, 1]
        return jnp.einsum('bhqk,bkhe->bqhe', attn.astype(v.dtype), v)

    o = lax.map(block, (qb, jnp.arange(nb)))
    o = jnp.moveaxis(o, 0, 1).reshape(bsz, s, DIFF_HEADS, DIFF_V_DIM)
    o = rms_norm(o, subln_w) * (1.0 - lambda_init)
    return o.reshape(bsz, s, DIFF_HEADS * DIFF_V_DIM) @ w_out


def setup_inputs(seed: int = 0) -> dict:
    key = jax.random.key(seed)
    ks = jax.random.split(key, 28)
    f32 = jnp.float32

    def nrm(k, shape, sd):
        return sd * jax.random.normal(k, shape, f32)

    x = jax.random.normal(ks[0], (BATCH, SEQ, D_MODEL), f32)
    even_w_in = nrm(ks[1], (N_EVEN, D_MODEL, EVEN_IN), D_MODEL ** -0.5)
    even_conv_w = nrm(ks[2], (N_EVEN, SSD_CONV, SSD_CONV_DIM), SSD_CONV ** -0.5)
    even_conv_b = nrm(ks[3], (N_EVEN, SSD_CONV_DIM), 0.01)
    dt0 = jnp.exp(jax.random.uniform(ks[4], (N_EVEN, SSD_HEADS), f32, math.log(1e-3), math.log(1e-1)))
    even_dt_bias = dt0 + jnp.log(-jnp.expm1(-dt0))
    even_a_log = jnp.log(jax.random.uniform(ks[5], (N_EVEN, SSD_HEADS), f32, 1.0, 16.0))
    even_d = 1.0 + nrm(ks[6], (N_EVEN, SSD_HEADS), 0.1)
    even_ssd_norm_w = 1.0 + nrm(ks[7], (N_EVEN, SSD_INNER), 0.02)
    even_sgu_ln_g = 1.0 + nrm(ks[8], (N_EVEN, SGU_WIDTH), 0.02)
    even_sgu_ln_b = nrm(ks[9], (N_EVEN, SGU_WIDTH), 0.02)
    even_sgu_w = nrm(ks[10], (N_EVEN, SGU_GROUPS, SGU_BLOCK, SGU_BLOCK), 0.5 * SGU_BLOCK ** -0.5)
    even_sgu_b = 1.0 + nrm(ks[11], (N_EVEN, SGU_GROUPS, SGU_BLOCK), 0.02)
    even_w_out = nrm(ks[12], (N_EVEN, EVEN_MIX, D_MODEL), EVEN_MIX ** -0.5 * DEEPNORM_BETA)
    w_qk = nrm(ks[13], (N_ODD, D_MODEL, 2 * DIFF_QK), D_MODEL ** -0.5)
    w_v = nrm(ks[14], (N_ODD, D_MODEL, DIFF_HEADS * DIFF_V_DIM), D_MODEL ** -0.5 * DEEPNORM_BETA)
    odd_w_qkv = jnp.concatenate([w_qk, w_v], axis=-1)
    odd_lambda_q1 = nrm(ks[15], (N_ODD, DIFF_HEAD_DIM), 0.1)
    odd_lambda_k1 = nrm(ks[16], (N_ODD, DIFF_HEAD_DIM), 0.1)
    odd_lambda_q2 = nrm(ks[17], (N_ODD, DIFF_HEAD_DIM), 0.1)
    odd_lambda_k2 = nrm(ks[18], (N_ODD, DIFF_HEAD_DIM), 0.1)
    odd_subln_w = 1.0 + nrm(ks[19], (N_ODD, DIFF_V_DIM), 0.02)
    odd_w_out = nrm(ks[20], (N_ODD, DIFF_HEADS * DIFF_V_DIM, D_MODEL),
                    (DIFF_HEADS * DIFF_V_DIM) ** -0.5 * DEEPNORM_BETA)
    ln_mix_g = 1.0 + nrm(ks[21], (DEPTH, D_MODEL), 0.02)
    ln_mix_b = nrm(ks[22], (DEPTH, D_MODEL), 0.02)
    ln_ffn_g = 1.0 + nrm(ks[23], (DEPTH, D_MODEL), 0.02)
    ln_ffn_b = nrm(ks[24], (DEPTH, D_MODEL), 0.02)
    mlp_w_up = nrm(ks[25], (DEPTH, D_MODEL, D_FF), D_MODEL ** -0.5 * DEEPNORM_BETA)
    mlp_w_down = nrm(ks[26], (DEPTH, D_FF, D_MODEL), D_FF ** -0.5 * DEEPNORM_BETA)
    return {'x': x, 'even_w_in': even_w_in, 'even_conv_w': even_conv_w, 'even_conv_b': even_conv_b,
            'even_dt_bias': even_dt_bias, 'even_a_log': even_a_log, 'even_d': even_d,
            'even_ssd_norm_w': even_ssd_norm_w, 'even_sgu_ln_g': even_sgu_ln_g,
            'even_sgu_ln_b': even_sgu_ln_b, 'even_sgu_w': even_sgu_w, 'even_sgu_b': even_sgu_b,
            'even_w_out': even_w_out, 'odd_w_qkv': odd_w_qkv, 'odd_lambda_q1': odd_lambda_q1,
            'odd_lambda_k1': odd_lambda_k1, 'odd_lambda_q2': odd_lambda_q2, 'odd_lambda_k2': odd_lambda_k2,
            'odd_subln_w': odd_subln_w, 'odd_w_out': odd_w_out, 'ln_mix_g': ln_mix_g, 'ln_mix_b': ln_mix_b,
            'ln_ffn_g': ln_ffn_g, 'ln_ffn_b': ln_ffn_b, 'mlp_w_up': mlp_w_up, 'mlp_w_down': mlp_w_down}


def reference(x, even_w_in, even_conv_w, even_conv_b, even_dt_bias, even_a_log, even_d,
              even_ssd_norm_w, even_sgu_ln_g, even_sgu_ln_b, even_sgu_w, even_sgu_b, even_w_out,
              odd_w_qkv, odd_lambda_q1, odd_lambda_k1, odd_lambda_q2, odd_lambda_k2, odd_subln_w,
              odd_w_out, ln_mix_g, ln_mix_b, ln_ffn_g, ln_ffn_b, mlp_w_up, mlp_w_down):
    h = x
    split_pts = [SSD_INNER, SSD_INNER + SSD_CONV_DIM, SSD_INNER + SSD_CONV_DIM + SSD_HEADS]
    for l in range(DEPTH):
        i = l // 2
        if l % 2 == 0:
            proj = h @ even_w_in[i]
            z, xbc, dt_raw, sgu_in = jnp.split(proj, split_pts, axis=-1)
            y_a = ssd_mixer(z, xbc, dt_raw, even_conv_w[i], even_conv_b[i], even_dt_bias[i],
                            even_a_log[i], even_d[i], even_ssd_norm_w[i])
            y_b = sgu_mixer(sgu_in, even_sgu_ln_g[i], even_sgu_ln_b[i], even_sgu_w[i], even_sgu_b[i])
            mix = jnp.concatenate([y_a, y_b], axis=-1) @ even_w_out[i]
        else:
            lambda_init = 0.8 - 0.6 * math.exp(-0.3 * l)
            mix = diff_attention(h, odd_w_qkv[i], odd_lambda_q1[i], odd_lambda_k1[i],
                                 odd_lambda_q2[i], odd_lambda_k2[i], odd_subln_w[i], odd_w_out[i],
                                 lambda_init)
        h = layer_norm(DEEPNORM_ALPHA * h + mix, ln_mix_g[l], ln_mix_b[l])
        f = jnp.square(jax.nn.relu(h @ mlp_w_up[l])) @ mlp_w_down[l]
        h = layer_norm(DEEPNORM_ALPHA * h + f, ln_ffn_g[l], ln_ffn_b[l])
    return h
```

```cpp
#include <hip/hip_runtime.h>
#include <hip/hip_cooperative_groups.h>
#include <cstdio>
#include <cstdint>
namespace cg = cooperative_groups;
namespace pg8 {
#define PG8_LAS __attribute__((address_space(3)))
typedef unsigned short bf16_t;
typedef short bf16x8 __attribute__((ext_vector_type(8)));
typedef float f32x4 __attribute__((ext_vector_type(4)));
typedef unsigned u32x4 __attribute__((ext_vector_type(4)));
constexpr int BM = 256, BK = 64, HALF = 128, HTB = HALF * BK * 2  , STAGE_BYTES = 8 * HTB, NXCD = 8, WGM = 8;

__host__ __device__ __forceinline__ int lds_byte(int r, int c) { const int st = (r >> 4) * 2 + (c >> 5), rr = r & 15, cc = c & 31, ob = rr * 64 + cc * 2; return st * 1024 + (ob ^ (((ob >> 9) & 1) << 5)); }
__host__ __device__ __forceinline__ void stage_rc(int b, int& R, int& C) { const int st = b / 1024, sb = b % 1024, swz = sb ^ (((sb >> 9) & 1) << 5); R = (st >> 1) * 16 + swz / 64; C = (st & 1) * 32 + (swz % 64) / 2; }
__host__ __device__ __forceinline__ int perm32(int rho) { const int n = rho >> 4, i = rho & 15; return 8 * (i >> 2) + 4 * n + (i & 3); }

struct Unit { int pm, pn; };
struct Gemm { const bf16_t* A; const bf16_t* Bt; int M, N, K; };

struct StaticOrder {
    int nM, nN, nwg, G, c;
    __host__ __device__ void init(int M, int N, int G_, int c_) { nM = M / BM; nN = N / BM; nwg = nM * nN; G = G_; c = c_; }
    __host__ __device__ bool next(int i, Unit& u) const {
        const long L = (long)i * G + c; if (L >= nwg) return false;
        int wgid = (int)L; { const int q = nwg / NXCD, r = nwg % NXCD, xcd = wgid % NXCD, off = wgid / NXCD; wgid = (xcd < r ? xcd * (q + 1) : r * (q + 1) + (xcd - r) * q) + off; }
        const int nig = WGM * nN, gid = wgid / nig, fm = gid * WGM, gsz = (nM - fm) < WGM ? (nM - fm) : WGM;
        u.pm = fm + ((wgid % nig) % gsz); u.pn = (wgid % nig) / gsz; return true;
    }
    __device__ __forceinline__ void a_ready(const Unit&) const {}
    __device__ __forceinline__ void done(const Unit&) const {}
};
__device__ __forceinline__ unsigned cvt_pk_bf16(float lo, float hi) { unsigned r; asm volatile("v_cvt_pk_bf16_f32 %0, %1, %2" : "=v"(r) : "v"(lo), "v"(hi)); return r; }
typedef float f32x2 __attribute__((ext_vector_type(2)));
__device__ __forceinline__ f32x2 gelu_pk(f32x2 v) {
    const f32x2 av = __builtin_elementwise_abs(v), d = av * 0.2316418882f + 1.0f;
    f32x2 t; t.x = __builtin_amdgcn_rcpf(d.x); t.y = __builtin_amdgcn_rcpf(d.y);
    f32x2 q = t * 0.5307027145f + (-0.7265760135f); q = q * t + 0.7107068705f; q = q * t + (-0.142248368f); q = q * t + 0.127414796f; q = q * t;
    const f32x2 s = (v * v) * (-0.72134752044f);
    f32x2 e; e.x = __builtin_amdgcn_exp2f(s.x); e.y = __builtin_amdgcn_exp2f(s.y);
    const f32x2 m = v * (q * e), r = v - m;
    f32x2 o; o.x = v.x < 0.f ? m.x : r.x; o.y = v.y < 0.f ? m.y : r.y; return o;
}
typedef unsigned u32x4e __attribute__((ext_vector_type(4)));
template <int ACT  > struct EpiPlain {
    static constexpr bool PERM = true, AFTER_DRAIN = false;
    bf16_t* O; int ldc;
    __device__ __forceinline__ void operator()(const f32x4 (&acc)[2][2][4][2], const Unit& u, int wr, int wc, int fr, int fq) const {
        const int row0 = u.pm * BM + wr * 64 + fr, col0 = u.pn * BM + wc * 32 + 8 * fq;
#pragma unroll
        for (int ai = 0; ai < 2; ++ai)
#pragma unroll
            for (int m = 0; m < 4; ++m) { bf16_t* rowp = O + (size_t)(row0 + ai * HALF + m * 16) * ldc + col0;
#pragma unroll
                for (int bj = 0; bj < 2; ++bj) { f32x4 v0 = acc[ai][bj][m][0], v1 = acc[ai][bj][m][1];
                    if (ACT == 2) {
#pragma unroll
                        for (int e = 0; e < 4; ++e) { const float a = v0[e] > 0.f ? v0[e] : 0.f, b = v1[e] > 0.f ? v1[e] : 0.f; v0[e] = a * a; v1[e] = b * b; } }
                    u32x4e w; w.x = cvt_pk_bf16(v0[0], v0[1]); w.y = cvt_pk_bf16(v0[2], v0[3]); w.z = cvt_pk_bf16(v1[0], v1[1]); w.w = cvt_pk_bf16(v1[2], v1[3]);
                    *(u32x4e*)(rowp + bj * HALF) = w; } }
    }
};
struct EpiInProj {
    static constexpr bool PERM = true, AFTER_DRAIN = false;
    bf16_t *Z, *XBC, *UV; float* DT;
    __device__ __forceinline__ void operator()(const f32x4 (&acc)[2][2][4][2], const Unit& u, int wr, int wc, int fr, int fq) const {
        const int row0 = u.pm * BM + wr * 64 + fr;
        if (u.pn == 18) {
            if (wc == 0 && fq < 2) {
#pragma unroll
                for (int ai = 0; ai < 2; ++ai)
#pragma unroll
                    for (int m = 0; m < 4; ++m) { float* rp = DT + (size_t)(row0 + ai * HALF + m * 16) * 16 + 8 * fq;
                        *(f32x4*)(rp) = acc[ai][0][m][0]; *(f32x4*)(rp + 4) = acc[ai][0][m][1]; }
            }
            return;
        }
        bf16_t* base; int ldc, colt; bool act;
        if (u.pn < 4) { base = Z; ldc = 1024; colt = u.pn * BM; act = false; }
        else if (u.pn < 10) { base = XBC; ldc = 1536; colt = (u.pn - 4) * BM; act = false; }
        else { base = UV; ldc = 2048; colt = (u.pn - 10) * BM; act = true; }
        const int col0 = colt + wc * 32 + 8 * fq;
#pragma unroll
        for (int ai = 0; ai < 2; ++ai)
#pragma unroll
            for (int m = 0; m < 4; ++m) { bf16_t* rowp = base + (size_t)(row0 + ai * HALF + m * 16) * ldc + col0;
#pragma unroll
                for (int bj = 0; bj < 2; ++bj) { f32x4 v0 = acc[ai][bj][m][0], v1 = acc[ai][bj][m][1];
                    if (act) { f32x2 a = gelu_pk((f32x2){v0[0], v0[1]}), b = gelu_pk((f32x2){v0[2], v0[3]}), c = gelu_pk((f32x2){v1[0], v1[1]}), d = gelu_pk((f32x2){v1[2], v1[3]});
                        v0 = (f32x4){a.x, a.y, b.x, b.y}; v1 = (f32x4){c.x, c.y, d.x, d.y}; }
                    u32x4e w; w.x = cvt_pk_bf16(v0[0], v0[1]); w.y = cvt_pk_bf16(v0[2], v0[3]); w.z = cvt_pk_bf16(v1[0], v1[1]); w.w = cvt_pk_bf16(v1[2], v1[3]);
                    *(u32x4e*)(rowp + bj * HALF) = w; } }
    }
};
struct EpiRes {
    static constexpr bool PERM = false, AFTER_DRAIN = false;
    const float* base; float* out; float alpha;
    __device__ __forceinline__ void operator()(const f32x4 (&acc)[2][2][4][2], const Unit& u, int wr, int wc, int fr, int fq) const {
        const int row0 = u.pm * BM + wr * 64 + fr, col0 = u.pn * BM + wc * 32 + 4 * fq;
#pragma unroll
        for (int ai = 0; ai < 2; ++ai)
#pragma unroll
            for (int m = 0; m < 4; ++m) { const size_t off = (size_t)(row0 + ai * HALF + m * 16) * 1024 + col0;
#pragma unroll
                for (int bj = 0; bj < 2; ++bj)
#pragma unroll
                    for (int n = 0; n < 2; ++n) { const f32x4 bs = *(const f32x4*)(base + off + bj * HALF + n * 16);
                        *(f32x4*)(out + off + bj * HALF + n * 16) = bs * alpha + acc[ai][bj][m][n]; } }
    }
};
template <class Epi, class Sched, bool ALIGN_EPI = false, bool SP2 = false>
__device__ __forceinline__ void gemm_phase(PG8_LAS unsigned char* lds, const Gemm g, const Sched& S, const Epi& E) {
    const int tid = threadIdx.x, wid = __builtin_amdgcn_readfirstlane(tid >> 6), lane = tid & 63, wr = wid >> 2, wc = wid & 3, fr = lane & 15, fq = lane >> 4;
    const int K = g.K, nt = K / BK;
    unsigned voffA[2], voffB[2];
#pragma unroll
    for (int i = 0; i < 2; ++i) { int R, C; stage_rc(tid * 16 + i * 8192, R, C); const int Rb = Epi::PERM ? ((R & ~31) + perm32(R & 31)) : R;
        voffA[i] = (unsigned)(R * K + C) * 2u; voffB[i] = (unsigned)(Rb * K + C) * 2u; }
    const size_t kstep = (size_t)(BK * 2);
    const size_t hstep = (size_t)HALF * K * 2;
    const size_t tstep = 2 * hstep;
    const unsigned ldsw = (unsigned)wid * 1024u;
    const int aoff = lds_byte(wr * 64 + fr, fq * 8), boff = lds_byte(wc * 32 + fr, fq * 8);
#define PG8_SA(b, h) (((b) * 2 + (h)) * HTB)
#define PG8_SB(b, h) ((4 + (b) * 2 + (h)) * HTB)
#define PG8_STAGE(bufoff, gbase, voff) do { _Pragma("unroll") for (int _i = 0; _i < 2; ++_i) \
        __builtin_amdgcn_global_load_lds((const unsigned*)((const char*)(gbase) + (voff)[_i]), (PG8_LAS unsigned*)(lds + (bufoff) + ldsw + _i * 8192), 16, 0, 0); } while (0)
#define PG8_LDA(dst, b, h) do { _Pragma("unroll") for (int m = 0; m < 4; ++m) _Pragma("unroll") for (int k = 0; k < 2; ++k) dst[m][k] = *(const PG8_LAS bf16x8*)(lds + PG8_SA(b, h) + aoff + m * 2048 + k * 1024); } while (0)
#define PG8_LDB(dst, b, h) do { _Pragma("unroll") for (int n = 0; n < 2; ++n) _Pragma("unroll") for (int k = 0; k < 2; ++k) dst[n][k] = *(const PG8_LAS bf16x8*)(lds + PG8_SB(b, h) + boff + n * 2048 + k * 1024); } while (0)
#define PG8_MMA(ai, bj, At, Bt) do { __builtin_amdgcn_s_setprio(1); _Pragma("unroll") for (int m = 0; m < 4; ++m) _Pragma("unroll") for (int n = 0; n < 2; ++n) _Pragma("unroll") for (int k = 0; k < 2; ++k) \
        acc[ai][bj][m][n] = __builtin_amdgcn_mfma_f32_16x16x32_bf16(Bt[n][k], At[m][k], acc[ai][bj][m][n], 0, 0, 0); __builtin_amdgcn_s_setprio(0); } while (0)
#define PG8_WAIT_V(n) asm volatile("s_waitcnt vmcnt(" #n ")" ::: "memory")
#define PG8_WAIT_L(n) asm volatile("s_waitcnt lgkmcnt(" #n ")" ::: "memory")
#define PG8_BAR __builtin_amdgcn_s_barrier()
#define PG8_SCHED __builtin_amdgcn_sched_barrier(0)
    Unit cur, nxt; int ui = 0;
    if (!S.next(0, cur)) return;
    f32x4 acc[2][2][4][2];
#pragma unroll
    for (int a = 0; a < 2; ++a)
#pragma unroll
        for (int b = 0; b < 2; ++b)
#pragma unroll
            for (int m = 0; m < 4; ++m)
#pragma unroll
                for (int n = 0; n < 2; ++n) acc[a][b][m][n] = (f32x4){0.f, 0.f, 0.f, 0.f};
    bf16x8 At[4][2], B0[2][2], B1[2][2];
    const char* cA = (const char*)g.A + (size_t)cur.pm * tstep; const char* cB = (const char*)g.Bt + (size_t)cur.pn * tstep;
    S.a_ready(cur);
    if constexpr (SP2) {
        PG8_STAGE(PG8_SB(0, 0), cB, voffB); PG8_STAGE(PG8_SB(0, 1), cB + hstep, voffB); PG8_STAGE(PG8_SA(0, 0), cA, voffA); PG8_STAGE(PG8_SA(0, 1), cA + hstep, voffA);
        if (wr == 1) PG8_BAR;
        PG8_WAIT_V(2); PG8_BAR;
        PG8_STAGE(PG8_SB(1, 0), cB + kstep, voffB); PG8_STAGE(PG8_SA(1, 0), cA + kstep, voffA); PG8_STAGE(PG8_SB(1, 1), cB + hstep + kstep, voffB);
        PG8_WAIT_V(6); PG8_BAR;
    } else {
        PG8_STAGE(PG8_SB(0, 0), cB, voffB); PG8_STAGE(PG8_SA(0, 0), cA, voffA); PG8_STAGE(PG8_SB(0, 1), cB + hstep, voffB); PG8_STAGE(PG8_SA(0, 1), cA + hstep, voffA);
        if (wr == 1) PG8_BAR;
        PG8_WAIT_V(4); PG8_BAR;
        PG8_STAGE(PG8_SB(1, 0), cB + kstep, voffB); PG8_STAGE(PG8_SA(1, 0), cA + kstep, voffA); PG8_STAGE(PG8_SB(1, 1), cB + hstep + kstep, voffB);
        PG8_WAIT_V(6); PG8_BAR;
    }
    for (;;) {
        const bool has_next = S.next(ui + 1, nxt);
        const char* nA = has_next ? (const char*)g.A + (size_t)nxt.pm * tstep : cA; const char* nB = has_next ? (const char*)g.Bt + (size_t)nxt.pn * tstep : cB;
        for (int t = 0; t < nt; t += 2) {
            const bool last = (t == nt - 2);
            const char* a1 = cA + (size_t)(t + 1) * kstep;
            const char* a2 = last ? nA : cA + (size_t)(t + 2) * kstep; const char* b2 = last ? nB : cB + (size_t)(t + 2) * kstep;
            const char* a3 = a2 + kstep; const char* b3 = b2 + kstep;
            if (last && has_next) S.a_ready(nxt);
            if constexpr (SP2) {
            PG8_LDB(B0, 0, 0); PG8_LDB(B1, 0, 1); PG8_SCHED; PG8_LDA(At, 0, 0); PG8_STAGE(PG8_SA(1, 1), a1 + hstep, voffA);
            PG8_WAIT_V(8); PG8_WAIT_L(0); PG8_BAR; PG8_MMA(0, 0, At, B0); PG8_MMA(0, 1, At, B1); PG8_BAR; PG8_SCHED;
            PG8_LDA(At, 0, 1); PG8_STAGE(PG8_SB(0, 0), b2, voffB); PG8_STAGE(PG8_SB(0, 1), b2 + hstep, voffB); PG8_STAGE(PG8_SA(0, 0), a2, voffA);
            PG8_WAIT_V(8); PG8_WAIT_L(0); PG8_BAR; PG8_MMA(1, 0, At, B0); PG8_MMA(1, 1, At, B1); PG8_BAR; PG8_SCHED;
            PG8_LDB(B0, 1, 0); PG8_LDB(B1, 1, 1); PG8_SCHED; PG8_LDA(At, 1, 0); PG8_STAGE(PG8_SA(0, 1), a2 + hstep, voffA);
            PG8_WAIT_V(8); PG8_WAIT_L(0); PG8_BAR; PG8_MMA(0, 0, At, B0); PG8_MMA(0, 1, At, B1); PG8_BAR; PG8_SCHED;
            PG8_LDA(At, 1, 1); PG8_STAGE(PG8_SB(1, 0), b3, voffB); PG8_STAGE(PG8_SB(1, 1), b3 + hstep, voffB); PG8_STAGE(PG8_SA(1, 0), a3, voffA);
            PG8_WAIT_V(8); PG8_WAIT_L(0); PG8_BAR; PG8_MMA(1, 0, At, B0); PG8_MMA(1, 1, At, B1); PG8_BAR; PG8_SCHED;
            } else {
            PG8_LDB(B0, 0, 0); PG8_SCHED; PG8_LDA(At, 0, 0); PG8_STAGE(PG8_SA(1, 1), a1 + hstep, voffA);
            PG8_WAIT_L(8); PG8_BAR; PG8_WAIT_L(0); PG8_MMA(0, 0, At, B0); PG8_BAR; PG8_SCHED;
            PG8_LDB(B1, 0, 1); PG8_STAGE(PG8_SB(0, 0), b2, voffB);
            PG8_BAR; PG8_WAIT_L(0); PG8_MMA(0, 1, At, B1); PG8_BAR;
            PG8_LDA(At, 0, 1); PG8_STAGE(PG8_SA(0, 0), a2, voffA);
            PG8_BAR; PG8_WAIT_L(0); PG8_MMA(1, 0, At, B0); PG8_BAR; PG8_SCHED;
            PG8_STAGE(PG8_SB(0, 1), b2 + hstep, voffB);
            PG8_WAIT_V(6); PG8_BAR; PG8_MMA(1, 1, At, B1); PG8_BAR;
            PG8_LDB(B0, 1, 0); PG8_SCHED; PG8_LDA(At, 1, 0); PG8_STAGE(PG8_SA(0, 1), a2 + hstep, voffA);
            PG8_WAIT_L(8); PG8_BAR; PG8_WAIT_L(0); PG8_MMA(0, 0, At, B0); PG8_BAR; PG8_SCHED;
            PG8_LDB(B1, 1, 1); PG8_STAGE(PG8_SB(1, 0), b3, voffB);
            PG8_BAR; PG8_WAIT_L(0); PG8_MMA(0, 1, At, B1); PG8_BAR;
            PG8_LDA(At, 1, 1); PG8_STAGE(PG8_SA(1, 0), a3, voffA);
            PG8_BAR; PG8_WAIT_L(0); PG8_MMA(1, 0, At, B0); PG8_BAR; PG8_SCHED;
            PG8_STAGE(PG8_SB(1, 1), b3 + hstep, voffB);
            PG8_WAIT_V(6); PG8_BAR; PG8_MMA(1, 1, At, B1); PG8_BAR;
            }
        }
        if constexpr (ALIGN_EPI) { if (wr == 0) PG8_BAR; }
        if constexpr (!Epi::AFTER_DRAIN) { E(acc, cur, wr, wc, fr, fq); S.done(cur); }
        if (!has_next) break;
#pragma unroll
        for (int a = 0; a < 2; ++a)
#pragma unroll
            for (int b = 0; b < 2; ++b)
#pragma unroll
                for (int m = 0; m < 4; ++m)
#pragma unroll
                    for (int n = 0; n < 2; ++n) acc[a][b][m][n] = (f32x4){0.f, 0.f, 0.f, 0.f};
        cur = nxt; cA = nA; cB = nB; ++ui;
        if constexpr (ALIGN_EPI) { if (wr == 1) PG8_BAR; }
    }
    PG8_WAIT_V(0);
    if constexpr (!ALIGN_EPI) { if (wr == 0) PG8_BAR; }
    PG8_BAR;
    if constexpr (Epi::AFTER_DRAIN) { E.fused(acc, cur, wr, wc, fr, fq, lds, wid, lane); S.done(cur); }
#undef PG8_SA
#undef PG8_SB
#undef PG8_STAGE
#undef PG8_LDA
#undef PG8_LDB
#undef PG8_MMA
#undef PG8_WAIT_V
#undef PG8_WAIT_L
#undef PG8_BAR
#undef PG8_SCHED
}
}

#define LAS __attribute__((address_space(3)))
typedef unsigned short bf16_t;
typedef short bf16x8 __attribute__((ext_vector_type(8)));
typedef float f32x4 __attribute__((ext_vector_type(4)));
typedef float f32x16 __attribute__((ext_vector_type(16)));
typedef unsigned u32x4 __attribute__((ext_vector_type(4)));
typedef unsigned u32x2 __attribute__((ext_vector_type(2)));
typedef float f32x2_t __attribute__((ext_vector_type(2)));
typedef __bf16 bf16x2_t __attribute__((ext_vector_type(2)));

constexpr int M = 32768, SEQ = 4096, DM = 1024, NB = 8;
constexpr int NWAVES = 8, NTHR = 512;
constexpr int LDS_BYTES = 147456;
constexpr float LN_EPS = 1e-5f;
constexpr float ALPHA = 1.4142135623730951f;
constexpr float LOG2E = 1.4426950408889634f;
constexpr float QSCALE = 0.125f * LOG2E;
constexpr float LAMBDA_INIT = 0.8f - 0.6f * 0.7408182206817179f;
constexpr int NPHASE = 17;

constexpr size_t MiB = 1u << 20;
constexpr size_t WS_WIN = 1 * MiB, WS_WOUT0 = 11 * MiB, WS_WUP0 = 15 * MiB, WS_WDN0 = 23 * MiB, WS_WQK = 31 * MiB, WS_WV = 35 * MiB,
                 WS_WO1 = 37 * MiB, WS_WUP1 = 39 * MiB, WS_WDN1 = 47 * MiB, WS_SGUW = 55 * MiB;
constexpr size_t WS_XB = 64 * MiB;
constexpr size_t WS_BIG = 128 * MiB;
constexpr size_t WS_XBC = 384 * MiB;
constexpr size_t WS_DT = 480 * MiB;
constexpr size_t WS_END = 482 * MiB;

__device__ __forceinline__ unsigned pk2(float lo, float hi) { f32x2_t v = {lo, hi}; bf16x2_t b = __builtin_convertvector(v, bf16x2_t); return __builtin_bit_cast(unsigned, b); }
__device__ __forceinline__ float bflo(unsigned u) { return __uint_as_float(u << 16); }
__device__ __forceinline__ float bfhi(unsigned u) { return __uint_as_float(u & 0xffff0000u); }
__device__ __forceinline__ float bf2f(bf16_t h) { return __uint_as_float((unsigned)h << 16); }
__device__ __forceinline__ bf16_t f2bf(float f) { return (bf16_t)(pk2(f, 0.f) & 0xffffu); }
__device__ __forceinline__ float wave_sum(float v) {
#pragma unroll
    for (int o = 1; o < 64; o <<= 1) v += __shfl_xor(v, o);
    return v;
}
__device__ __forceinline__ float sigmoidf_(float x) { return 1.0f / (1.0f + __expf(-x)); }
#define MFMA16(a, b, c) __builtin_amdgcn_mfma_f32_16x16x32_bf16((a), (b), (c), 0, 0, 0)
#define MFMA32(a, b, c) __builtin_amdgcn_mfma_f32_32x32x16_bf16((a), (b), (c), 0, 0, 0)

__device__ __forceinline__ void tr_item(const float* W, int ld, int c0, bf16_t* WT, int K, int row0, float scale, LAS float* scr, int kb, int nb, int lane) {
    const int k0 = 64 * kb, n0 = 32 * nb;
#pragma unroll 8
    for (int i = 0; i < 32; ++i) { const int kk = 2 * i + (lane >> 5); scr[kk * 33 + (lane & 31)] = W[(size_t)(k0 + kk) * ld + c0 + n0 + (lane & 31)] * scale; }
    asm volatile("s_waitcnt lgkmcnt(0)" ::: "memory");
    const int c = lane & 7;
#pragma unroll
    for (int j = 0; j < 4; ++j) { const int n = (lane >> 3) + 8 * j; const LAS float* s = scr + (8 * c) * 33 + n;
        u32x4 o; o.x = pk2(s[0 * 33], s[1 * 33]); o.y = pk2(s[2 * 33], s[3 * 33]); o.z = pk2(s[4 * 33], s[5 * 33]); o.w = pk2(s[6 * 33], s[7 * 33]);
        *(u32x4*)(WT + (size_t)(row0 + n0 + n) * K + k0 + 8 * c) = o; }
    asm volatile("s_waitcnt lgkmcnt(0)" ::: "memory");
}
struct P0Args { const float *x, *w_in, *w_out0, *w_up, *w_dn, *w_qkv, *w_o1, *sgu_w; unsigned char* ws; };
__device__ __forceinline__ void p0_prologue(LAS unsigned char* lds, const P0Args& a, int G) {
    const int tid = threadIdx.x, lane = tid & 63, wid = __builtin_amdgcn_readfirstlane(tid >> 6);
    LAS float* scr = (LAS float*)(lds + wid * 16384);
    const int gw = blockIdx.x * NWAVES + wid, NGW = G * NWAVES;
    bf16_t* WIN = (bf16_t*)(a.ws + WS_WIN);
#define TR_MAT(src, ld, c0, ncols, dst, K, row0, scale) { const int nblk = (ncols) / 32, nit = ((K) / 64) * nblk; \
        if (r < nit) { tr_item((src), (ld), (c0), (dst), (K), (row0), (scale), scr, r / nblk, r % nblk, lane); continue; } r -= nit; }
    constexpr int NIT = 16 * 80 + 16 * 64 + 32 * 32 + 2 * (16 * 128) + 2 * (64 * 32) + 16 * 32 + 16 * 32 + 16 * 32 + 16 * 32;
    for (int it = gw; it < NIT; it += NGW) {
        int r = it;
        TR_MAT(a.w_in, 4624, 0, 2560, WIN, 1024, 0, 1.f)
        TR_MAT(a.w_in, 4624, 2576, 2048, WIN, 1024, 2560, 1.f)
        TR_MAT(a.w_out0, 1024, 0, 1024, (bf16_t*)(a.ws + WS_WOUT0), 2048, 0, 1.f)
        TR_MAT(a.w_up, 4096, 0, 4096, (bf16_t*)(a.ws + WS_WUP0), 1024, 0, 1.f)
        TR_MAT(a.w_up + (size_t)1024 * 4096, 4096, 0, 4096, (bf16_t*)(a.ws + WS_WUP1), 1024, 0, 1.f)
        TR_MAT(a.w_dn, 1024, 0, 1024, (bf16_t*)(a.ws + WS_WDN0), 4096, 0, 1.f)
        TR_MAT(a.w_dn + (size_t)4096 * 1024, 1024, 0, 1024, (bf16_t*)(a.ws + WS_WDN1), 4096, 0, 1.f)
        TR_MAT(a.w_qkv, 3072, 0, 1024, (bf16_t*)(a.ws + WS_WQK), 1024, 0, QSCALE)
        TR_MAT(a.w_qkv, 3072, 1024, 1024, (bf16_t*)(a.ws + WS_WQK), 1024, 1024, 1.f)
        TR_MAT(a.w_qkv, 3072, 2048, 1024, (bf16_t*)(a.ws + WS_WV), 1024, 0, 1.f)
        TR_MAT(a.w_o1, 1024, 0, 1024, (bf16_t*)(a.ws + WS_WO1), 1024, 0, 1.f)
    }
#undef TR_MAT
    const size_t gt = (size_t)blockIdx.x * NTHR + tid, NGT = (size_t)G * NTHR;
    for (size_t i = gt; i < (size_t)256 * 1024; i += NGT) { const int n = (int)(i >> 10), k = (int)(i & 1023);
        WIN[(size_t)(4608 + n) * 1024 + k] = n < 16 ? f2bf(a.w_in[(size_t)k * 4624 + 2560 + n]) : (bf16_t)0; }
    bf16_t* SW = (bf16_t*)(a.ws + WS_SGUW);
    for (size_t i = gt; i < (size_t)8 * 128 * 128; i += NGT) { const int s = (int)(i & 127), t = (int)((i >> 7) & 127);
        SW[i] = ((t >> 6) >= (s >> 6)) ? f2bf(a.sgu_w[i]) : (bf16_t)0; }
    bf16_t* XB = (bf16_t*)(a.ws + WS_XB);
    for (size_t i = gt; i < (size_t)M * DM / 8; i += NGT) { const f32x4 v0 = *(const f32x4*)(a.x + i * 8), v1 = *(const f32x4*)(a.x + i * 8 + 4);
        u32x4 o; o.x = pk2(v0[0], v0[1]); o.y = pk2(v0[2], v0[3]); o.z = pk2(v1[0], v1[1]); o.w = pk2(v1[2], v1[3]); *(u32x4*)(XB + i * 8) = o; }
}

__device__ __forceinline__ void ln_phase(float* buf, bf16_t* xb, const float* g, const float* b, int G) {
    const int tid = threadIdx.x, lane = tid & 63, wid = tid >> 6;
    const int gw = blockIdx.x * NWAVES + wid, NGW = G * NWAVES;
    f32x4 gv[4], bv[4];
#pragma unroll
    for (int j = 0; j < 4; ++j) { gv[j] = *(const f32x4*)(g + lane * 4 + 256 * j); bv[j] = *(const f32x4*)(b + lane * 4 + 256 * j); }
    for (int m = gw; m < M; m += NGW) {
        float* row = buf + (size_t)m * DM + lane * 4;
        f32x4 v[4]; float s = 0.f;
#pragma unroll
        for (int j = 0; j < 4; ++j) { v[j] = *(const f32x4*)(row + 256 * j); s += (v[j][0] + v[j][1]) + (v[j][2] + v[j][3]); }
        const float mean = wave_sum(s) * (1.f / DM); float s2 = 0.f;
#pragma unroll
        for (int j = 0; j < 4; ++j) { v[j] = v[j] - mean; s2 += (v[j][0] * v[j][0] + v[j][1] * v[j][1]) + (v[j][2] * v[j][2] + v[j][3] * v[j][3]); }
        const float rstd = 1.f / sqrtf(wave_sum(s2) * (1.f / DM) + LN_EPS);
        bf16_t* xr = xb + (size_t)m * DM + lane * 4;
#pragma unroll
        for (int j = 0; j < 4; ++j) { const f32x4 o = v[j] * rstd * gv[j] + bv[j]; *(f32x4*)(row + 256 * j) = o;
            u32x2 w; w.x = pk2(o[0], o[1]); w.y = pk2(o[2], o[3]); *(u32x2*)(xr + 256 * j) = w; }
    }
}

struct SsdArgs { const bf16_t* XBC; const float* DT; bf16_t* Y; const float *conv_w, *conv_b, *dt_bias, *a_log, *d_skip; };
__device__ __forceinline__ void ssd_load(u32x4 (&raw)[7], const bf16_t* XBC, int b, int c, int rr, int colg) {
#pragma unroll
    for (int i = 0; i < 7; ++i) { const int tr = c * 64 + 4 * rr - 3 + i;
        raw[i] = tr >= 0 ? *(const u32x4*)(XBC + (size_t)(b * SEQ + tr) * 1536 + colg) : (u32x4){0u, 0u, 0u, 0u}; }
}
__device__ __forceinline__ void ssd_conv_task(const u32x4 (&raw)[7], int cgi, int rr, const float (&wj)[4], LAS float* CW, LAS bf16_t* Bs, LAS bf16_t* Cs, LAS bf16_t* BsT,
                                              LAS bf16_t* xT, LAS bf16_t* xwT, LAS float* xs) {
    u32x4 pack[4];
#pragma unroll
    for (int ep = 0; ep < 4; ++ep) {
        float i0[7], i1[7];
#pragma unroll
        for (int i = 0; i < 7; ++i) { const unsigned u = raw[i][ep]; i0[i] = bflo(u); i1[i] = bfhi(u); }
        const int lc = cgi * 8 + 2 * ep;
        float w0[5], w1[5];
#pragma unroll
        for (int k = 0; k < 5; ++k) { w0[k] = CW[k * 288 + lc]; w1[k] = CW[k * 288 + lc + 1]; }
        float o0[4], o1[4];
#pragma unroll
        for (int j = 0; j < 4; ++j) { float a = w0[4], c = w1[4];
#pragma unroll
            for (int k = 0; k < 4; ++k) { a += w0[k] * i0[j + k]; c += w1[k] * i1[j + k]; }
            o0[j] = a * sigmoidf_(a); o1[j] = c * sigmoidf_(c); }
#pragma unroll
        for (int j = 0; j < 4; ++j) pack[j][ep] = pk2(o0[j], o1[j]);
        if (cgi < 4) {
            const int p = cgi * 8 + 2 * ep;
#pragma unroll
            for (int j = 0; j < 4; ++j) { xs[(4 * rr + j) * 33 + p] = o0[j]; xs[(4 * rr + j) * 33 + p + 1] = o1[j]; }
            *(LAS u32x2*)(xT + p * 72 + 4 * rr) = (u32x2){pk2(o0[0], o0[1]), pk2(o0[2], o0[3])};
            *(LAS u32x2*)(xT + (p + 1) * 72 + 4 * rr) = (u32x2){pk2(o1[0], o1[1]), pk2(o1[2], o1[3])};
            *(LAS u32x2*)(xwT + p * 72 + 4 * rr) = (u32x2){pk2(o0[0] * wj[0], o0[1] * wj[1]), pk2(o0[2] * wj[2], o0[3] * wj[3])};
            *(LAS u32x2*)(xwT + (p + 1) * 72 + 4 * rr) = (u32x2){pk2(o1[0] * wj[0], o1[1] * wj[1]), pk2(o1[2] * wj[2], o1[3] * wj[3])};
        } else if (cgi < 20) {
            const int n = (cgi - 4) * 8 + 2 * ep;
            *(LAS u32x2*)(BsT + n * 72 + 4 * rr) = (u32x2){pk2(o0[0], o0[1]), pk2(o0[2], o0[3])};
            *(LAS u32x2*)(BsT + (n + 1) * 72 + 4 * rr) = (u32x2){pk2(o1[0], o1[1]), pk2(o1[2], o1[3])};
        }
    }
    if (cgi >= 4 && cgi < 20) {
#pragma unroll
        for (int j = 0; j < 4; ++j) *(LAS u32x4*)(Bs + (4 * rr + j) * 136 + (cgi - 4) * 8) = pack[j];
    } else if (cgi >= 20) {
#pragma unroll
        for (int j = 0; j < 4; ++j) *(LAS u32x4*)(Cs + (4 * rr + j) * 136 + (cgi - 20) * 8) = pack[j];
    }
}
__device__ __forceinline__ void ssd_phase(LAS unsigned char* lds, const SsdArgs& A, int G) {
    const int tid = threadIdx.x, lane = tid & 63, wid = __builtin_amdgcn_readfirstlane(tid >> 6), l15 = lane & 15, quad = lane >> 4;
    LAS float* CW = (LAS float*)(lds);
    LAS float* DTS = (LAS float*)(lds + 6144);
    LAS bf16_t* Bs = (LAS bf16_t*)(lds + 8192);
    LAS bf16_t* Cs = Bs + 64 * 136;
    LAS bf16_t* BsT = Cs + 64 * 136;
    LAS bf16_t* xT = BsT + 128 * 72;
    LAS bf16_t* xwT = xT + 32 * 72;
    LAS bf16_t* Lm = xwT + 32 * 72;
    LAS bf16_t* St = Lm + 64 * 72;
    LAS float* xs = (LAS float*)(St + 32 * 136);
    for (int item = blockIdx.x; item < 256; item += G) {
        const int b = item >> 5, h = (item >> 1) & 15, ph = item & 1, g = h >> 3;
        __syncthreads();
        for (int idx = tid; idx < 5 * 288; idx += NTHR) { const int k = idx / 288, lc = idx % 288;
            const int col = lc < 32 ? h * 64 + ph * 32 + lc : (lc < 160 ? 1024 + g * 128 + (lc - 32) : 1280 + g * 128 + (lc - 160));
            CW[idx] = k < 4 ? A.conv_w[k * 1536 + col] : A.conv_b[col]; }
        for (int idx = tid; idx < 32 * 136 / 2; idx += NTHR) ((LAS unsigned*)St)[idx] = 0u;
        const float a_h = -__expf(A.a_log[h]), dtb = A.dt_bias[h], Dh = A.d_skip[h];
        const int cg0 = tid % 36, rr0 = tid / 36, cg1 = (tid + 512) % 36, rr1 = (tid + 512) / 36;
        const int colg0 = cg0 < 4 ? h * 64 + ph * 32 + cg0 * 8 : (cg0 < 20 ? 1024 + g * 128 + (cg0 - 4) * 8 : 1280 + g * 128 + (cg0 - 20) * 8);
        const int colg1 = cg1 < 4 ? h * 64 + ph * 32 + cg1 * 8 : (cg1 < 20 ? 1024 + g * 128 + (cg1 - 4) * 8 : 1280 + g * 128 + (cg1 - 20) * 8);
        u32x4 raw0[7], raw1[7]; float dtraw;
        ssd_load(raw0, A.XBC, b, 0, rr0, colg0);
        if (tid < 64) ssd_load(raw1, A.XBC, b, 0, rr1, colg1);
        dtraw = A.DT[(size_t)(b * SEQ + lane) * 16 + h];
        f32x4 state[2]; state[0] = (f32x4){0.f, 0.f, 0.f, 0.f}; state[1] = (f32x4){0.f, 0.f, 0.f, 0.f};
        __syncthreads();
        for (int c = 0; c < 64; ++c) {
            const int rowbase = b * SEQ + c * 64;
            const float xdt = dtraw + dtb; const float dtv = xdt > 20.f ? xdt : log1pf(__expf(xdt));
            float acs = dtv * a_h;
#pragma unroll
            for (int off = 1; off < 64; off <<= 1) { const float t = __shfl_up(acs, off); if (lane >= off) acs += t; }
            const float acs63 = __shfl(acs, 63);
            const float wl = dtv * __expf(acs63 - acs);
            if (wid == 0) { DTS[lane] = dtv; DTS[64 + lane] = acs; DTS[128 + lane] = __expf(acs); }
            float wj0[4], wj1[4];
#pragma unroll
            for (int j = 0; j < 4; ++j) { wj0[j] = __shfl(wl, (4 * rr0 + j) & 63); wj1[j] = __shfl(wl, (4 * rr1 + j) & 63); }
            ssd_conv_task(raw0, cg0, rr0, wj0, CW, Bs, Cs, BsT, xT, xwT, xs);
            if (tid < 64) ssd_conv_task(raw1, cg1, rr1, wj1, CW, Bs, Cs, BsT, xT, xwT, xs);
            __syncthreads();
            if (c < 63) { ssd_load(raw0, A.XBC, b, c + 1, rr0, colg0); if (tid < 64) ssd_load(raw1, A.XBC, b, c + 1, rr1, colg1);
                dtraw = A.DT[(size_t)(rowbase + 64 + lane) * 16 + h]; }
            { const int ti = wid & 3, sjb = (wid >> 2) * 2;
#pragma unroll
              for (int q = 0; q < 2; ++q) { const int sj = sjb + q; f32x4 acc = (f32x4){0.f, 0.f, 0.f, 0.f};
                if (sj <= ti) {
#pragma unroll
                    for (int kk = 0; kk < 4; ++kk) { const bf16x8 av = *(const LAS bf16x8*)(Cs + (16 * ti + l15) * 136 + kk * 32 + quad * 8);
                        const bf16x8 bv = *(const LAS bf16x8*)(Bs + (16 * sj + l15) * 136 + kk * 32 + quad * 8); acc = MFMA16(av, bv, acc); }
                }
                const int s = 16 * sj + l15; const float acs_s = DTS[64 + s], dt_s = DTS[s];
#pragma unroll
                for (int r = 0; r < 4; ++r) { const int t = 16 * ti + 4 * quad + r; const float acs_t = DTS[64 + t];
                    const float v = (s <= t) ? acc[r] * __expf(acs_t - acs_s) * dt_s : 0.f; Lm[t * 72 + s] = f2bf(v); } } }
            __syncthreads();
            { const int ti = wid & 3, pj = wid >> 2; f32x4 accd = (f32x4){0.f, 0.f, 0.f, 0.f}, acco = (f32x4){0.f, 0.f, 0.f, 0.f};
#pragma unroll
              for (int kk = 0; kk < 2; ++kk) { const bf16x8 av = *(const LAS bf16x8*)(Lm + (16 * ti + l15) * 72 + kk * 32 + quad * 8);
                  const bf16x8 bv = *(const LAS bf16x8*)(xT + (16 * pj + l15) * 72 + kk * 32 + quad * 8); accd = MFMA16(av, bv, accd); }
#pragma unroll
              for (int kk = 0; kk < 4; ++kk) { const bf16x8 av = *(const LAS bf16x8*)(Cs + (16 * ti + l15) * 136 + kk * 32 + quad * 8);
                  const bf16x8 bv = *(const LAS bf16x8*)(St + (16 * pj + l15) * 136 + kk * 32 + quad * 8); acco = MFMA16(av, bv, acco); }
              const int p = 16 * pj + l15;
#pragma unroll
              for (int r = 0; r < 4; ++r) { const int t = 16 * ti + 4 * quad + r; const float y = accd[r] + DTS[128 + t] * acco[r] + Dh * xs[t * 33 + p];
                  A.Y[(size_t)(rowbase + t) * 1024 + h * 64 + ph * 32 + p] = f2bf(y); } }
            const int pi = wid & 1, njb = (wid >> 1) * 2; const float dec = __expf(acs63);
#pragma unroll
            for (int q = 0; q < 2; ++q) { const int nj = njb + q; f32x4 acc = (f32x4){0.f, 0.f, 0.f, 0.f};
#pragma unroll
                for (int kk = 0; kk < 2; ++kk) { const bf16x8 av = *(const LAS bf16x8*)(xwT + (16 * pi + l15) * 72 + kk * 32 + quad * 8);
                    const bf16x8 bv = *(const LAS bf16x8*)(BsT + (16 * nj + l15) * 72 + kk * 32 + quad * 8); acc = MFMA16(av, bv, acc); }
                state[q] = state[q] * dec + acc; }
            __syncthreads();
#pragma unroll
            for (int q = 0; q < 2; ++q)
#pragma unroll
                for (int r = 0; r < 4; ++r) St[(16 * pi + 4 * quad + r) * 136 + 16 * (njb + q) + l15] = f2bf(state[q][r]);
        }
    }
}

struct MixArgs { const bf16_t *Y, *Z, *UV, *SW; bf16_t* MIX; const float *norm_w, *ln_g, *ln_b, *sgu_b; };
__device__ __forceinline__ void mix_phase(LAS unsigned char* lds, const MixArgs& A, int G) {
    const int tid = threadIdx.x, lane = tid & 63, wid = __builtin_amdgcn_readfirstlane(tid >> 6), l15 = lane & 15, quad = lane >> 4;
    LAS float* stats = (LAS float*)lds;
    LAS bf16_t* VnT0 = (LAS bf16_t*)(lds + 1024);
    for (int u = blockIdx.x; u < M / 128; u += G) {
        const int m0 = u * 128;
        __syncthreads();
        for (int rr = wid; rr < 128; rr += NWAVES) {
            const size_t m = (size_t)(m0 + rr);
#pragma unroll
            for (int gi = 0; gi < 2; ++gi) {
                const int col = gi * 512 + lane * 8;
                const u32x4 yv = *(const u32x4*)(A.Y + m * 1024 + col), zv = *(const u32x4*)(A.Z + m * 1024 + col);
                float v[8]; float ss = 0.f;
#pragma unroll
                for (int e = 0; e < 4; ++e) { const float z0 = bflo(zv[e]), z1 = bfhi(zv[e]); v[2 * e] = bflo(yv[e]) * z0 * sigmoidf_(z0); v[2 * e + 1] = bfhi(yv[e]) * z1 * sigmoidf_(z1);
                    ss += v[2 * e] * v[2 * e] + v[2 * e + 1] * v[2 * e + 1]; }
                const float rs = 1.f / sqrtf(wave_sum(ss) * (1.f / 512.f) + LN_EPS);
                const f32x4 w0 = *(const f32x4*)(A.norm_w + col), w1 = *(const f32x4*)(A.norm_w + col + 4);
                u32x4 o; o.x = pk2(v[0] * rs * w0[0], v[1] * rs * w0[1]); o.y = pk2(v[2] * rs * w0[2], v[3] * rs * w0[3]);
                o.z = pk2(v[4] * rs * w1[0], v[5] * rs * w1[1]); o.w = pk2(v[6] * rs * w1[2], v[7] * rs * w1[3]);
                *(u32x4*)(A.MIX + m * 2048 + col) = o;
            }
            { const bf16_t* vr = A.UV + m * 2048 + 1024;
              const u32x4 a0 = *(const u32x4*)(vr + lane * 8), a1 = *(const u32x4*)(vr + 512 + lane * 8);
              float v[16]; float s = 0.f;
#pragma unroll
              for (int e = 0; e < 4; ++e) { v[2 * e] = bflo(a0[e]); v[2 * e + 1] = bfhi(a0[e]); v[8 + 2 * e] = bflo(a1[e]); v[8 + 2 * e + 1] = bfhi(a1[e]); }
#pragma unroll
              for (int e = 0; e < 16; ++e) s += v[e];
              const float mean = wave_sum(s) * (1.f / 1024.f); float s2 = 0.f;
#pragma unroll
              for (int e = 0; e < 16; ++e) { const float d = v[e] - mean; s2 += d * d; }
              const float rstd = 1.f / sqrtf(wave_sum(s2) * (1.f / 1024.f) + LN_EPS);
              if (lane == 0) { stats[2 * rr] = mean; stats[2 * rr + 1] = rstd; } }
        }
        __syncthreads();
        for (int gi = 0; gi < 8; ++gi) {
            LAS bf16_t* buf = VnT0 + (gi & 1) * (128 * 136);
#pragma unroll
            for (int i = 0; i < 4; ++i) { const int task = tid + NTHR * i, s = task & 127, cgp = task >> 7;
                const u32x4 vv = *(const u32x4*)(A.UV + (size_t)(m0 + s) * 2048 + 1024 + gi * 128 + cgp * 8);
                const float mean = stats[2 * s], rstd = stats[2 * s + 1];
                const f32x4 g0 = *(const f32x4*)(A.ln_g + gi * 128 + cgp * 8), g1 = *(const f32x4*)(A.ln_g + gi * 128 + cgp * 8 + 4);
                const f32x4 b0 = *(const f32x4*)(A.ln_b + gi * 128 + cgp * 8), b1 = *(const f32x4*)(A.ln_b + gi * 128 + cgp * 8 + 4);
#pragma unroll
                for (int e = 0; e < 4; ++e) { const float gA = e < 2 ? g0[2 * e] : g1[2 * e - 4], gB = e < 2 ? g0[2 * e + 1] : g1[2 * e - 3];
                    const float bA = e < 2 ? b0[2 * e] : b1[2 * e - 4], bB = e < 2 ? b0[2 * e + 1] : b1[2 * e - 3];
                    buf[(cgp * 8 + 2 * e) * 136 + s] = f2bf((bflo(vv[e]) - mean) * rstd * gA + bA);
                    buf[(cgp * 8 + 2 * e + 1) * 136 + s] = f2bf((bfhi(vv[e]) - mean) * rstd * gB + bB); } }
            __syncthreads();
            bf16x8 af[4];
#pragma unroll
            for (int kk = 0; kk < 4; ++kk) af[kk] = *(const bf16x8*)(A.SW + (size_t)gi * 16384 + (16 * wid + l15) * 128 + kk * 32 + quad * 8);
            float bias[4];
#pragma unroll
            for (int r = 0; r < 4; ++r) bias[r] = A.sgu_b[gi * 128 + 16 * wid + 4 * quad + r];
#pragma unroll 2
            for (int cj = 0; cj < 8; ++cj) { f32x4 acc = (f32x4){0.f, 0.f, 0.f, 0.f};
#pragma unroll
                for (int kk = 0; kk < 4; ++kk) { const bf16x8 bv = *(const LAS bf16x8*)(buf + (16 * cj + l15) * 136 + kk * 32 + quad * 8); acc = MFMA16(af[kk], bv, acc); }
#pragma unroll
                for (int r = 0; r < 4; ++r) { const size_t m = (size_t)(m0 + 16 * wid + 4 * quad + r); const int c = gi * 128 + 16 * cj + l15;
                    const float uval = bf2f(A.UV[m * 2048 + c]); A.MIX[m * 2048 + 1024 + c] = f2bf(uval * (acc[r] + bias[r])); } }
        }
    }
}

struct AttnArgs { const bf16_t *QK, *VT; bf16_t* AO; const float *lq1, *lk1, *lq2, *lk2, *subw; };
__device__ __forceinline__ int crow(int i, int hh) { return (i & 3) + 8 * (i >> 2) + 4 * hh; }
__device__ __forceinline__ void attn_phase(LAS unsigned char* lds, const AttnArgs& A, int G) {
    const int tid = threadIdx.x, lane = tid & 63, wid = __builtin_amdgcn_readfirstlane(tid >> 6), r = lane & 31, hh = lane >> 5;
    const int map = wid & 1, rg = wid >> 1;
    const float lam = __expf(wave_sum(A.lq1[lane] * A.lk1[lane])) - __expf(wave_sum(A.lq2[lane] * A.lk2[lane])) + LAMBDA_INIT;
    LAS bf16_t* Kbuf = (LAS bf16_t*)lds;
    LAS bf16_t* Vbuf = (LAS bf16_t*)(lds + 34816);
    LAS float* wsf = (LAS float*)(lds + 71680) + wid * 64;
    LAS float* XCH = (LAS float*)lds + rg * 4096;
    for (int vb = blockIdx.x; vb < 256; vb += G) {
        const int bh = vb >> 2, b = bh >> 3, h = bh & 7, sx = vb & 3;
        const float slope2 = exp2f(-(float)(h + 1)) * LOG2E;
        const int rowb = b * SEQ;
        for (int ui = 0; ui < 8; ++ui) {
            const int qb = (ui & 1) ? 8 * (ui >> 1) + 7 - sx : 8 * (ui >> 1) + sx;
            const int q0 = qb * 128, qc = 2 * qb + (rg >> 1), T0 = 2 * qb + 1;
            bf16x8 qf[4];
#pragma unroll
            for (int s = 0; s < 4; ++s) qf[s] = *(const bf16x8*)(A.QK + (size_t)(rowb + q0 + 32 * rg + r) * 2048 + h * 128 + map * 64 + 16 * s + 8 * hh);
            f32x16 O[4];
#pragma unroll
            for (int db = 0; db < 4; ++db)
#pragma unroll
                for (int i = 0; i < 16; ++i) O[db][i] = 0.f;
            float m_run = -1e30f, l_run = 0.f;
            const int krow0 = tid >> 4, kcp = tid & 15, vd0 = tid >> 3, vcp = tid & 7;
            const bf16_t* ksrc = A.QK + (size_t)(rowb + krow0) * 2048 + 1024 + h * 128 + kcp * 8;
            const bf16_t* vsrc = A.VT + (size_t)(h * 128 + vd0) * M + rowb + vcp * 8;
            u32x4 kr0, kr1, vr0, vr1;
#define ATT_LOAD(kt) do { kr0 = *(const u32x4*)(ksrc + (size_t)((kt) * 64) * 2048); kr1 = *(const u32x4*)(ksrc + (size_t)((kt) * 64 + 32) * 2048); \
                          vr0 = *(const u32x4*)(vsrc + (kt) * 64); vr1 = *(const u32x4*)(vsrc + (size_t)64 * M + (kt) * 64); } while (0)
#define ATT_WRITE(bufi) do { *(LAS u32x4*)(Kbuf + (bufi) * (64 * 136) + krow0 * 136 + kcp * 8) = kr0; *(LAS u32x4*)(Kbuf + (bufi) * (64 * 136) + (krow0 + 32) * 136 + kcp * 8) = kr1; \
                             *(LAS u32x4*)(Vbuf + (bufi) * (128 * 72) + vd0 * 72 + vcp * 8) = vr0; *(LAS u32x4*)(Vbuf + (bufi) * (128 * 72) + (vd0 + 64) * 72 + vcp * 8) = vr1; } while (0)
            __syncthreads();
            ATT_LOAD(T0); ATT_WRITE(0);
            __syncthreads();
            int cur = 0;
            for (int kt = T0; kt >= 0; --kt) {
                if (kt > 0) ATT_LOAD(kt - 1);
                if (kt <= qc) {
                    const LAS bf16_t* Kb = Kbuf + cur * (64 * 136); const LAS bf16_t* Vb = Vbuf + cur * (128 * 72);
                    f32x16 sv[2];
#pragma unroll
                    for (int kb = 0; kb < 2; ++kb) {
#pragma unroll
                        for (int i = 0; i < 16; ++i) sv[kb][i] = 0.f;
#pragma unroll
                        for (int s = 0; s < 4; ++s) { const bf16x8 av = *(const LAS bf16x8*)(Kb + (32 * kb + r) * 136 + map * 64 + 16 * s + 8 * hh); sv[kb] = MFMA32(av, qf[s], sv[kb]); }
                    }
                    const float basef = (float)(q0 + 32 * rg + r - kt * 64 - 4 * hh);
                    float mx = -1e30f;
#pragma unroll
                    for (int kb = 0; kb < 2; ++kb)
#pragma unroll
                        for (int i = 0; i < 16; ++i) { const float cst = (float)(32 * kb + (i & 3) + 8 * (i >> 2)); const float v = sv[kb][i] - slope2 * fabsf(basef - cst); sv[kb][i] = v; mx = fmaxf(mx, v); }
                    mx = fmaxf(mx, __shfl_xor(mx, 32));
                    const float m_new = fmaxf(m_run, mx);
                    if (__any(m_new > m_run)) {
                        const float alpha = exp2f(m_run - m_new); l_run *= alpha; m_run = m_new;
                        if (hh == 0) wsf[r] = alpha;
#pragma unroll
                        for (int i = 0; i < 16; ++i) { const float al = wsf[crow(i, hh)];
#pragma unroll
                            for (int db = 0; db < 4; ++db) O[db][i] *= al; }
                    }
                    float ps = 0.f;
#pragma unroll
                    for (int kb = 0; kb < 2; ++kb)
#pragma unroll
                        for (int i = 0; i < 16; ++i) { const float p = exp2f(sv[kb][i] - m_run); sv[kb][i] = p; ps += p; }
                    l_run += ps;
#pragma unroll
                    for (int s2 = 0; s2 < 4; ++s2) { const int kb = s2 >> 1, hf = s2 & 1;
                        u32x4 pw; pw.x = pk2(sv[kb][8 * hf + 0], sv[kb][8 * hf + 1]); pw.y = pk2(sv[kb][8 * hf + 2], sv[kb][8 * hf + 3]);
                        pw.z = pk2(sv[kb][8 * hf + 4], sv[kb][8 * hf + 5]); pw.w = pk2(sv[kb][8 * hf + 6], sv[kb][8 * hf + 7]);
                        const bf16x8 pa = __builtin_bit_cast(bf16x8, pw);
#pragma unroll
                        for (int db = 0; db < 4; ++db) { const LAS bf16_t* vp = Vb + (32 * db + r) * 72 + 32 * kb + 16 * hf + 4 * hh;
                            const u32x2 lo = *(const LAS u32x2*)(vp), hi = *(const LAS u32x2*)(vp + 8);
                            u32x4 vw; vw.x = lo.x; vw.y = lo.y; vw.z = hi.x; vw.w = hi.y;
                            O[db] = MFMA32(pa, __builtin_bit_cast(bf16x8, vw), O[db]); } }
                }
                if (kt > 0) ATT_WRITE(cur ^ 1);
                __syncthreads();
                cur ^= 1;
            }
#undef ATT_LOAD
#undef ATT_WRITE
            const float l_tot = l_run + __shfl_xor(l_run, 32);
            if (hh == 0) wsf[32 + r] = 1.f / l_tot;
#pragma unroll
            for (int i = 0; i < 16; ++i) { const float li = wsf[32 + crow(i, hh)];
#pragma unroll
                for (int db = 0; db < 4; ++db) O[db][i] *= li; }
            if (map == 1) {
#pragma unroll
                for (int db = 0; db < 4; ++db)
#pragma unroll
                    for (int i = 0; i < 16; ++i) XCH[(db * 16 + i) * 64 + lane] = O[db][i];
            }
            __syncthreads();
            if (map == 0) {
                float ss[16];
#pragma unroll
                for (int i = 0; i < 16; ++i) { float a = 0.f;
#pragma unroll
                    for (int db = 0; db < 4; ++db) { const float o = O[db][i] - lam * XCH[(db * 16 + i) * 64 + lane]; O[db][i] = o; a += o * o; }
                    ss[i] = a; }
#pragma unroll
                for (int i = 0; i < 16; ++i) {
#pragma unroll
                    for (int o = 1; o < 32; o <<= 1) ss[i] += __shfl_xor(ss[i], o);
                    ss[i] = (1.f - LAMBDA_INIT) / sqrtf(ss[i] * (1.f / 128.f) + LN_EPS); }
#pragma unroll
                for (int db = 0; db < 4; ++db) { const float w = A.subw[32 * db + r];
#pragma unroll
                    for (int i = 0; i < 16; ++i) A.AO[(size_t)(rowb + q0 + 32 * rg + crow(i, hh)) * 1024 + h * 128 + 32 * db + r] = f2bf(O[db][i] * ss[i] * w); }
            }
        }
    }
}

struct Args { const float* in[26]; float* out; unsigned char* ws; int ph_lo, ph_hi; };
__global__ void __launch_bounds__(NTHR, 2) mega_fwd(Args args) {
    extern __shared__ __attribute__((aligned(16))) unsigned char lds_raw[];
    LAS unsigned char* lds = (LAS unsigned char*)lds_raw;
    cg::grid_group grid = cg::this_grid();
    const int G = gridDim.x;
    unsigned char* ws = args.ws;
    float* out = args.out;
    bf16_t* XB = (bf16_t*)(ws + WS_XB);
    bf16_t* MIX = (bf16_t*)(ws + WS_BIG);
    bf16_t* UV = (bf16_t*)(ws + WS_BIG + 128 * MiB);
    bf16_t* FF = (bf16_t*)(ws + WS_BIG);
    bf16_t* QK = (bf16_t*)(ws + WS_BIG);
    bf16_t* VT = (bf16_t*)(ws + WS_BIG + 128 * MiB);
    bf16_t* AO = (bf16_t*)(ws + WS_BIG + 192 * MiB);
    bf16_t* XBC = (bf16_t*)(ws + WS_XBC);
    float* DT = (float*)(ws + WS_DT);
    bf16_t* Zb = (bf16_t*)out;
    bf16_t* Yb = (bf16_t*)out + (size_t)M * 1024;
    const int lo = args.ph_lo, hi = args.ph_hi;
#ifndef ONLY
#define EN(k) 1
#else
#define EN(k) ((ONLY)==(k))
#endif
#define IN(k) (EN(k) && lo <= (k) && (k) < hi)
#define SEAM(k) do { if ((k) + 1 < hi) grid.sync(); } while (0)
#define GEMM_RES(k, Aop, Wt, Kdim, rbase) if (IN(k)) { pg8::Gemm g{(Aop), (const bf16_t*)(ws + (Wt)), M, 1024, (Kdim)}; pg8::StaticOrder S; S.init(M, 1024, G, (int)blockIdx.x); \
        pg8::EpiRes E{(rbase), out, ALPHA}; pg8::gemm_phase<pg8::EpiRes, pg8::StaticOrder, true, true>(lds, g, S, E); SEAM(k); }
#define GEMM_UP(k, Wt) if (IN(k)) { pg8::Gemm g{XB, (const bf16_t*)(ws + (Wt)), M, 4096, 1024}; pg8::StaticOrder S; S.init(M, 4096, G, (int)blockIdx.x); \
        pg8::EpiPlain<2> E{FF, 4096}; pg8::gemm_phase<pg8::EpiPlain<2>, pg8::StaticOrder, true, true>(lds, g, S, E); SEAM(k); }
#define LNPH(k, gi, bi, l) if (IN(k)) { ln_phase(out, XB, args.in[gi] + (l) * 1024, args.in[bi] + (l) * 1024, G); SEAM(k); }
    if (IN(0)) { P0Args a{args.in[0], args.in[1], args.in[12], args.in[24], args.in[25], args.in[13], args.in[19], args.in[10], ws}; p0_prologue(lds, a, G); SEAM(0); }
    if (IN(1)) { pg8::Gemm g{XB, (const bf16_t*)(ws + WS_WIN), M, 4864, 1024}; pg8::StaticOrder S; S.init(M, 4864, G, (int)blockIdx.x);
                 pg8::EpiInProj E{Zb, XBC, UV, DT}; pg8::gemm_phase<pg8::EpiInProj, pg8::StaticOrder, true, true>(lds, g, S, E); SEAM(1); }
    if (IN(2)) { SsdArgs a{XBC, DT, Yb, args.in[2], args.in[3], args.in[4], args.in[5], args.in[6]}; ssd_phase(lds, a, G); SEAM(2); }
    if (IN(3)) { MixArgs a{Yb, Zb, UV, (const bf16_t*)(ws + WS_SGUW), MIX, args.in[7], args.in[8], args.in[9], args.in[11]}; mix_phase(lds, a, G); SEAM(3); }
    GEMM_RES(4, MIX, WS_WOUT0, 2048, args.in[0])
    LNPH(5, 20, 21, 0)
    GEMM_UP(6, WS_WUP0)
    GEMM_RES(7, FF, WS_WDN0, 4096, out)
    LNPH(8, 22, 23, 0)
    if (IN(9)) { pg8::Gemm g{XB, (const bf16_t*)(ws + WS_WQK), M, 2048, 1024}; pg8::StaticOrder S; S.init(M, 2048, G, (int)blockIdx.x);
                 pg8::EpiPlain<0> E{QK, 2048}; pg8::gemm_phase<pg8::EpiPlain<0>, pg8::StaticOrder, true, true>(lds, g, S, E); SEAM(9); }
    if (IN(10)) { pg8::Gemm g{(const bf16_t*)(ws + WS_WV), XB, 1024, M, 1024}; pg8::StaticOrder S; S.init(1024, M, G, (int)blockIdx.x);
                 pg8::EpiPlain<0> E{VT, M}; pg8::gemm_phase<pg8::EpiPlain<0>, pg8::StaticOrder, true, true>(lds, g, S, E); SEAM(10); }
    if (IN(11)) { AttnArgs a{QK, VT, AO, args.in[14], args.in[15], args.in[16], args.in[17], args.in[18]}; attn_phase(lds, a, G); SEAM(11); }
    GEMM_RES(12, AO, WS_WO1, 1024, out)
    LNPH(13, 20, 21, 1)
    GEMM_UP(14, WS_WUP1)
    GEMM_RES(15, FF, WS_WDN1, 4096, out)
    LNPH(16, 22, 23, 1)
}

extern "C" void kernel_launch(void* const* d_in, const int* in_sizes, int n_in, void* d_out, int out_size, void* d_ws, size_t ws_size, hipStream_t stream) {
    static int grid = 0;
    if (grid == 0) {
        if (n_in != 26 || out_size != M * DM || ws_size < WS_END) { fprintf(stderr, "kernel_launch: unexpected shapes (n_in %d out %d ws %zu)\n", n_in, out_size, ws_size); grid = -1; return; }
        int dev = 0, cus = 0, per_cu = 0;
        hipGetDevice(&dev); hipDeviceGetAttribute(&cus, hipDeviceAttributeMultiprocessorCount, dev);
        if (hipFuncSetAttribute((const void*)mega_fwd, hipFuncAttributeMaxDynamicSharedMemorySize, LDS_BYTES) != hipSuccess) { fprintf(stderr, "kernel_launch: hipFuncSetAttribute failed\n"); grid = -1; return; }
        if (hipOccupancyMaxActiveBlocksPerMultiprocessor(&per_cu, (const void*)mega_fwd, NTHR, LDS_BYTES) != hipSuccess || per_cu < 1) { fprintf(stderr, "kernel_launch: occupancy query gives %d\n", per_cu); per_cu = 1; }
        (void)hipGetLastError();
        grid = cus * (per_cu > 1 ? 1 : per_cu);
        if (grid <= 0) grid = 256;
    }
    if (grid < 0) return;
    Args a{};
    for (int i = 0; i < 26; ++i) a.in[i] = (const float*)d_in[i];
    a.out = (float*)d_out; a.ws = (unsigned char*)d_ws; a.ph_lo = 0; a.ph_hi = NPHASE;
    void* kargs[] = {&a};
    hipError_t e = hipLaunchCooperativeKernel((const void*)mega_fwd, dim3(grid), dim3(NTHR), kargs, LDS_BYTES, stream);
    if (e != hipSuccess) fprintf(stderr, "kernel_launch: cooperative launch failed: %s (grid %d)\n", hipGetErrorString(e), grid);
}
```

```cpp
#include <hip/hip_runtime.h>
#include <hip/hip_cooperative_groups.h>
#include <cstdio>
#include <cstdint>
namespace cg = cooperative_groups;
#define LAS __attribute__((address_space(3)))
namespace pg8 {
#define PG8_LAS __attribute__((address_space(3)))
typedef unsigned short bf16_t;
typedef short bf16x8 __attribute__((ext_vector_type(8)));
typedef float f32x4 __attribute__((ext_vector_type(4)));
typedef unsigned u32x4 __attribute__((ext_vector_type(4)));
constexpr int BM = 256, BK = 64, HALF = 128, HTB = HALF * BK * 2  , STAGE_BYTES = 8 * HTB, NXCD = 8, WGM = 8;

__host__ __device__ __forceinline__ int lds_byte(int r, int c) { const int st = (r >> 4) * 2 + (c >> 5), rr = r & 15, cc = c & 31, ob = rr * 64 + cc * 2; return st * 1024 + (ob ^ (((ob >> 9) & 1) << 5)); }
__host__ __device__ __forceinline__ void stage_rc(int b, int& R, int& C) { const int st = b / 1024, sb = b % 1024, swz = sb ^ (((sb >> 9) & 1) << 5); R = (st >> 1) * 16 + swz / 64; C = (st & 1) * 32 + (swz % 64) / 2; }
__host__ __device__ __forceinline__ int perm32(int rho) { const int n = rho >> 4, i = rho & 15; return 8 * (i >> 2) + 4 * n + (i & 3); }

struct Unit { int pm, pn; };
struct Gemm { const bf16_t* A; const bf16_t* Bt; int M, N, K; };

struct StaticOrder {
    int nM, nN, nwg, G, c;
    __host__ __device__ void init(int M, int N, int G_, int c_) { nM = M / BM; nN = N / BM; nwg = nM * nN; G = G_; c = c_; }
    __host__ __device__ bool next(int i, Unit& u) const {
        const long L = (long)i * G + c; if (L >= nwg) return false;
        int wgid = (int)L; { const int q = nwg / NXCD, r = nwg % NXCD, xcd = wgid % NXCD, off = wgid / NXCD; wgid = (xcd < r ? xcd * (q + 1) : r * (q + 1) + (xcd - r) * q) + off; }
        const int nig = WGM * nN, gid = wgid / nig, fm = gid * WGM, gsz = (nM - fm) < WGM ? (nM - fm) : WGM;
        u.pm = fm + ((wgid % nig) % gsz); u.pn = (wgid % nig) / gsz; return true;
    }
    __device__ __forceinline__ void a_ready(const Unit&) const {}
    __device__ __forceinline__ void done(const Unit&) const {}
};
__device__ __forceinline__ unsigned cvt_pk_bf16(float lo, float hi) { unsigned r; asm volatile("v_cvt_pk_bf16_f32 %0, %1, %2" : "=v"(r) : "v"(lo), "v"(hi)); return r; }
typedef float f32x2 __attribute__((ext_vector_type(2)));
__device__ __forceinline__ f32x2 gelu_pk(f32x2 v) {
    const f32x2 av = __builtin_elementwise_abs(v), d = av * 0.2316418882f + 1.0f;
    f32x2 t; t.x = __builtin_amdgcn_rcpf(d.x); t.y = __builtin_amdgcn_rcpf(d.y);
    f32x2 q = t * 0.5307027145f + (-0.7265760135f); q = q * t + 0.7107068705f; q = q * t + (-0.142248368f); q = q * t + 0.127414796f; q = q * t;
    const f32x2 s = (v * v) * (-0.72134752044f);
    f32x2 e; e.x = __builtin_amdgcn_exp2f(s.x); e.y = __builtin_amdgcn_exp2f(s.y);
    const f32x2 m = v * (q * e), r = v - m;
    f32x2 o; o.x = v.x < 0.f ? m.x : r.x; o.y = v.y < 0.f ? m.y : r.y; return o;
}
typedef unsigned u32x4e __attribute__((ext_vector_type(4)));
template <int ACT  > struct EpiPlain {
    static constexpr bool PERM = true, AFTER_DRAIN = false;
    bf16_t* O; int ldc;
    __device__ __forceinline__ void operator()(const f32x4 (&acc)[2][2][4][2], const Unit& u, int wr, int wc, int fr, int fq) const {
        const int row0 = u.pm * BM + wr * 64 + fr, col0 = u.pn * BM + wc * 32 + 8 * fq;
#pragma unroll
        for (int ai = 0; ai < 2; ++ai)
#pragma unroll
            for (int m = 0; m < 4; ++m) { bf16_t* rowp = O + (size_t)(row0 + ai * HALF + m * 16) * ldc + col0;
#pragma unroll
                for (int bj = 0; bj < 2; ++bj) { f32x4 v0 = acc[ai][bj][m][0], v1 = acc[ai][bj][m][1];
                    if (ACT == 2) {
#pragma unroll
                        for (int e = 0; e < 4; ++e) { const float a = v0[e] > 0.f ? v0[e] : 0.f, b = v1[e] > 0.f ? v1[e] : 0.f; v0[e] = a * a; v1[e] = b * b; } }
                    u32x4e w; w.x = cvt_pk_bf16(v0[0], v0[1]); w.y = cvt_pk_bf16(v0[2], v0[3]); w.z = cvt_pk_bf16(v1[0], v1[1]); w.w = cvt_pk_bf16(v1[2], v1[3]);
                    *(u32x4e*)(rowp + bj * HALF) = w; } }
    }
};
struct EpiInProj {
    static constexpr bool PERM = true, AFTER_DRAIN = false;
    bf16_t *Z, *XBC, *UV; float* DT;
    __device__ __forceinline__ void operator()(const f32x4 (&acc)[2][2][4][2], const Unit& u, int wr, int wc, int fr, int fq) const {
        const int row0 = u.pm * BM + wr * 64 + fr;
        if (u.pn == 18) {
            if (wc == 0 && fq < 2) {
#pragma unroll
                for (int ai = 0; ai < 2; ++ai)
#pragma unroll
                    for (int m = 0; m < 4; ++m) { float* rp = DT + (size_t)(row0 + ai * HALF + m * 16) * 16 + 8 * fq;
                        *(f32x4*)(rp) = acc[ai][0][m][0]; *(f32x4*)(rp + 4) = acc[ai][0][m][1]; }
            }
            return;
        }
        bf16_t* base; int ldc, colt; bool act;
        if (u.pn < 4) { base = Z; ldc = 1024; colt = u.pn * BM; act = false; }
        else if (u.pn < 10) { base = XBC; ldc = 1536; colt = (u.pn - 4) * BM; act = false; }
        else { base = UV; ldc = 2048; colt = (u.pn - 10) * BM; act = true; }
        const int col0 = colt + wc * 32 + 8 * fq;
#pragma unroll
        for (int ai = 0; ai < 2; ++ai)
#pragma unroll
            for (int m = 0; m < 4; ++m) { bf16_t* rowp = base + (size_t)(row0 + ai * HALF + m * 16) * ldc + col0;
#pragma unroll
                for (int bj = 0; bj < 2; ++bj) { f32x4 v0 = acc[ai][bj][m][0], v1 = acc[ai][bj][m][1];
                    if (act) { f32x2 a = gelu_pk((f32x2){v0[0], v0[1]}), b = gelu_pk((f32x2){v0[2], v0[3]}), c = gelu_pk((f32x2){v1[0], v1[1]}), d = gelu_pk((f32x2){v1[2], v1[3]});
                        v0 = (f32x4){a.x, a.y, b.x, b.y}; v1 = (f32x4){c.x, c.y, d.x, d.y}; }
                    u32x4e w; w.x = cvt_pk_bf16(v0[0], v0[1]); w.y = cvt_pk_bf16(v0[2], v0[3]); w.z = cvt_pk_bf16(v1[0], v1[1]); w.w = cvt_pk_bf16(v1[2], v1[3]);
                    *(u32x4e*)(rowp + bj * HALF) = w; } }
    }
};
struct EpiRes {
    static constexpr bool PERM = false, AFTER_DRAIN = false;
    const float* base; float* out; float alpha;
    __device__ __forceinline__ void operator()(const f32x4 (&acc)[2][2][4][2], const Unit& u, int wr, int wc, int fr, int fq) const {
        const int row0 = u.pm * BM + wr * 64 + fr, col0 = u.pn * BM + wc * 32 + 4 * fq;
#pragma unroll
        for (int ai = 0; ai < 2; ++ai)
#pragma unroll
            for (int m = 0; m < 4; ++m) { const size_t off = (size_t)(row0 + ai * HALF + m * 16) * 1024 + col0;
#pragma unroll
                for (int bj = 0; bj < 2; ++bj)
#pragma unroll
                    for (int n = 0; n < 2; ++n) { const f32x4 bs = *(const f32x4*)(base + off + bj * HALF + n * 16);
                        *(f32x4*)(out + off + bj * HALF + n * 16) = bs * alpha + acc[ai][bj][m][n]; } }
    }
};
template <class Epi, class Sched, bool ALIGN_EPI = false, bool SP2 = false>
__device__ __forceinline__ void gemm_phase(PG8_LAS unsigned char* lds, const Gemm g, const Sched& S, const Epi& E) {
    const int tid = threadIdx.x, wid = __builtin_amdgcn_readfirstlane(tid >> 6), lane = tid & 63, wr = wid >> 2, wc = wid & 3, fr = lane & 15, fq = lane >> 4;
    const int K = g.K, nt = K / BK;
    unsigned voffA[2], voffB[2];
#pragma unroll
    for (int i = 0; i < 2; ++i) { int R, C; stage_rc(tid * 16 + i * 8192, R, C); const int Rb = Epi::PERM ? ((R & ~31) + perm32(R & 31)) : R;
        voffA[i] = (unsigned)(R * K + C) * 2u; voffB[i] = (unsigned)(Rb * K + C) * 2u; }
    const size_t kstep = (size_t)(BK * 2);
    const size_t hstep = (size_t)HALF * K * 2;
    const size_t tstep = 2 * hstep;
    const unsigned ldsw = (unsigned)wid * 1024u;
    const int aoff = lds_byte(wr * 64 + fr, fq * 8), boff = lds_byte(wc * 32 + fr, fq * 8);
#define PG8_SA(b, h) (((b) * 2 + (h)) * HTB)
#define PG8_SB(b, h) ((4 + (b) * 2 + (h)) * HTB)
#define PG8_STAGE(bufoff, gbase, voff) do { _Pragma("unroll") for (int _i = 0; _i < 2; ++_i) \
        __builtin_amdgcn_global_load_lds((const unsigned*)((const char*)(gbase) + (voff)[_i]), (PG8_LAS unsigned*)(lds + (bufoff) + ldsw + _i * 8192), 16, 0, 0); } while (0)
#define PG8_LDA(dst, b, h) do { _Pragma("unroll") for (int m = 0; m < 4; ++m) _Pragma("unroll") for (int k = 0; k < 2; ++k) dst[m][k] = *(const PG8_LAS bf16x8*)(lds + PG8_SA(b, h) + aoff + m * 2048 + k * 1024); } while (0)
#define PG8_LDB(dst, b, h) do { _Pragma("unroll") for (int n = 0; n < 2; ++n) _Pragma("unroll") for (int k = 0; k < 2; ++k) dst[n][k] = *(const PG8_LAS bf16x8*)(lds + PG8_SB(b, h) + boff + n * 2048 + k * 1024); } while (0)
#define PG8_MMA(ai, bj, At, Bt) do { __builtin_amdgcn_s_setprio(1); _Pragma("unroll") for (int m = 0; m < 4; ++m) _Pragma("unroll") for (int n = 0; n < 2; ++n) _Pragma("unroll") for (int k = 0; k < 2; ++k) \
        acc[ai][bj][m][n] = __builtin_amdgcn_mfma_f32_16x16x32_bf16(Bt[n][k], At[m][k], acc[ai][bj][m][n], 0, 0, 0); __builtin_amdgcn_s_setprio(0); } while (0)
#define PG8_WAIT_V(n) asm volatile("s_waitcnt vmcnt(" #n ")" ::: "memory")
#define PG8_WAIT_L(n) asm volatile("s_waitcnt lgkmcnt(" #n ")" ::: "memory")
#define PG8_BAR __builtin_amdgcn_s_barrier()
#define PG8_SCHED __builtin_amdgcn_sched_barrier(0)
    Unit cur, nxt; int ui = 0;
    if (!S.next(0, cur)) return;
    f32x4 acc[2][2][4][2];
#pragma unroll
    for (int a = 0; a < 2; ++a)
#pragma unroll
        for (int b = 0; b < 2; ++b)
#pragma unroll
            for (int m = 0; m < 4; ++m)
#pragma unroll
                for (int n = 0; n < 2; ++n) acc[a][b][m][n] = (f32x4){0.f, 0.f, 0.f, 0.f};
    bf16x8 At[4][2], B0[2][2], B1[2][2];
    const char* cA = (const char*)g.A + (size_t)cur.pm * tstep; const char* cB = (const char*)g.Bt + (size_t)cur.pn * tstep;
    S.a_ready(cur);
    if constexpr (SP2) {
        PG8_STAGE(PG8_SB(0, 0), cB, voffB); PG8_STAGE(PG8_SB(0, 1), cB + hstep, voffB); PG8_STAGE(PG8_SA(0, 0), cA, voffA); PG8_STAGE(PG8_SA(0, 1), cA + hstep, voffA);
        if (wr == 1) PG8_BAR;
        PG8_WAIT_V(2); PG8_BAR;
        PG8_STAGE(PG8_SB(1, 0), cB + kstep, voffB); PG8_STAGE(PG8_SA(1, 0), cA + kstep, voffA); PG8_STAGE(PG8_SB(1, 1), cB + hstep + kstep, voffB);
        PG8_WAIT_V(6); PG8_BAR;
    } else {
        PG8_STAGE(PG8_SB(0, 0), cB, voffB); PG8_STAGE(PG8_SA(0, 0), cA, voffA); PG8_STAGE(PG8_SB(0, 1), cB + hstep, voffB); PG8_STAGE(PG8_SA(0, 1), cA + hstep, voffA);
        if (wr == 1) PG8_BAR;
        PG8_WAIT_V(4); PG8_BAR;
        PG8_STAGE(PG8_SB(1, 0), cB + kstep, voffB); PG8_STAGE(PG8_SA(1, 0), cA + kstep, voffA); PG8_STAGE(PG8_SB(1, 1), cB + hstep + kstep, voffB);
        PG8_WAIT_V(6); PG8_BAR;
    }
    for (;;) {
        const bool has_next = S.next(ui + 1, nxt);
        const char* nA = has_next ? (const char*)g.A + (size_t)nxt.pm * tstep : cA; const char* nB = has_next ? (const char*)g.Bt + (size_t)nxt.pn * tstep : cB;
        for (int t = 0; t < nt; t += 2) {
            const bool last = (t == nt - 2);
            const char* a1 = cA + (size_t)(t + 1) * kstep;
            const char* a2 = last ? nA : cA + (size_t)(t + 2) * kstep; const char* b2 = last ? nB : cB + (size_t)(t + 2) * kstep;
            const char* a3 = a2 + kstep; const char* b3 = b2 + kstep;
            if (last && has_next) S.a_ready(nxt);
            if constexpr (SP2) {
            PG8_LDB(B0, 0, 0); PG8_LDB(B1, 0, 1); PG8_SCHED; PG8_LDA(At, 0, 0); PG8_STAGE(PG8_SA(1, 1), a1 + hstep, voffA);
            PG8_WAIT_V(8); PG8_WAIT_L(0); PG8_BAR; PG8_MMA(0, 0, At, B0); PG8_MMA(0, 1, At, B1); PG8_BAR; PG8_SCHED;
            PG8_LDA(At, 0, 1); PG8_STAGE(PG8_SB(0, 0), b2, voffB); PG8_STAGE(PG8_SB(0, 1), b2 + hstep, voffB); PG8_STAGE(PG8_SA(0, 0), a2, voffA);
            PG8_WAIT_V(8); PG8_WAIT_L(0); PG8_BAR; PG8_MMA(1, 0, At, B0); PG8_MMA(1, 1, At, B1); PG8_BAR; PG8_SCHED;
            PG8_LDB(B0, 1, 0); PG8_LDB(B1, 1, 1); PG8_SCHED; PG8_LDA(At, 1, 0); PG8_STAGE(PG8_SA(0, 1), a2 + hstep, voffA);
            PG8_WAIT_V(8); PG8_WAIT_L(0); PG8_BAR; PG8_MMA(0, 0, At, B0); PG8_MMA(0, 1, At, B1); PG8_BAR; PG8_SCHED;
            PG8_LDA(At, 1, 1); PG8_STAGE(PG8_SB(1, 0), b3, voffB); PG8_STAGE(PG8_SB(1, 1), b3 + hstep, voffB); PG8_STAGE(PG8_SA(1, 0), a3, voffA);
            PG8_WAIT_V(8); PG8_WAIT_L(0); PG8_BAR; PG8_MMA(1, 0, At, B0); PG8_MMA(1, 1, At, B1); PG8_BAR; PG8_SCHED;
            } else {
            PG8_LDB(B0, 0, 0); PG8_SCHED; PG8_LDA(At, 0, 0); PG8_STAGE(PG8_SA(1, 1), a1 + hstep, voffA);
            PG8_WAIT_L(8); PG8_BAR; PG8_WAIT_L(0); PG8_MMA(0, 0, At, B0); PG8_BAR; PG8_SCHED;
            PG8_LDB(B1, 0, 1); PG8_STAGE(PG8_SB(0, 0), b2, voffB);
            PG8_BAR; PG8_WAIT_L(0); PG8_MMA(0, 1, At, B1); PG8_BAR;
            PG8_LDA(At, 0, 1); PG8_STAGE(PG8_SA(0, 0), a2, voffA);
            PG8_BAR; PG8_WAIT_L(0); PG8_MMA(1, 0, At, B0); PG8_BAR; PG8_SCHED;
            PG8_STAGE(PG8_SB(0, 1), b2 + hstep, voffB);
            PG8_WAIT_V(6); PG8_BAR; PG8_MMA(1, 1, At, B1); PG8_BAR;
            PG8_LDB(B0, 1, 0); PG8_SCHED; PG8_LDA(At, 1, 0); PG8_STAGE(PG8_SA(0, 1), a2 + hstep, voffA);
            PG8_WAIT_L(8); PG8_BAR; PG8_WAIT_L(0); PG8_MMA(0, 0, At, B0); PG8_BAR; PG8_SCHED;
            PG8_LDB(B1, 1, 1); PG8_STAGE(PG8_SB(1, 0), b3, voffB);
            PG8_BAR; PG8_WAIT_L(0); PG8_MMA(0, 1, At, B1); PG8_BAR;
            PG8_LDA(At, 1, 1); PG8_STAGE(PG8_SA(1, 0), a3, voffA);
            PG8_BAR; PG8_WAIT_L(0); PG8_MMA(1, 0, At, B0); PG8_BAR; PG8_SCHED;
            PG8_STAGE(PG8_SB(1, 1), b3 + hstep, voffB);
            PG8_WAIT_V(6); PG8_BAR; PG8_MMA(1, 1, At, B1); PG8_BAR;
            }
        }
        if constexpr (ALIGN_EPI) { if (wr == 0) PG8_BAR; }
        if constexpr (!Epi::AFTER_DRAIN) { E(acc, cur, wr, wc, fr, fq); S.done(cur); }
        if (!has_next) break;
#pragma unroll
        for (int a = 0; a < 2; ++a)
#pragma unroll
            for (int b = 0; b < 2; ++b)
#pragma unroll
                for (int m = 0; m < 4; ++m)
#pragma unroll
                    for (int n = 0; n < 2; ++n) acc[a][b][m][n] = (f32x4){0.f, 0.f, 0.f, 0.f};
        cur = nxt; cA = nA; cB = nB; ++ui;
        if constexpr (ALIGN_EPI) { if (wr == 1) PG8_BAR; }
    }
    PG8_WAIT_V(0);
    if constexpr (!ALIGN_EPI) { if (wr == 0) PG8_BAR; }
    PG8_BAR;
    if constexpr (Epi::AFTER_DRAIN) { E.fused(acc, cur, wr, wc, fr, fq, lds, wid, lane); S.done(cur); }
#undef PG8_SA
#undef PG8_SB
#undef PG8_STAGE
#undef PG8_LDA
#undef PG8_LDB
#undef PG8_MMA
#undef PG8_WAIT_V
#undef PG8_WAIT_L
#undef PG8_BAR
#undef PG8_SCHED
}
}
#define XB_TMO      128
#define XB_XCNT(j)  (256  + 64 * (j))
#define XB_XSUB(j)  (1280 + 64 * (j))
#define XB_XGEN(j)  (2304 + 64 * (j))
#define XB_TOP      3328
#define XB_TOPGEN   3392
#define XCD_BAR_WORDS 3456
#define XB_SPIN_CAP (1u << 18)

__device__ __forceinline__ unsigned xb_ld(unsigned* p)              { return __hip_atomic_load(p, __ATOMIC_RELAXED, __HIP_MEMORY_SCOPE_AGENT); }
__device__ __forceinline__ unsigned xb_add(unsigned* p, unsigned v) { return __hip_atomic_fetch_add(p, v, __ATOMIC_RELAXED, __HIP_MEMORY_SCOPE_AGENT); }
__device__ __forceinline__ unsigned xb_xcc_id() { return (unsigned)__builtin_amdgcn_s_getreg((3 << 11) | 20) & 0xFu; }
#define XB_SPIN(cond, bar) do { unsigned _sp = 0; while (cond) { __builtin_amdgcn_s_sleep(1); \
    if ((++_sp & 255u) == 0u) { if (xb_ld(&(bar)[XB_TMO])) break; if (_sp > XB_SPIN_CAP) { atomicAdd(&(bar)[XB_TMO], 1u); break; } } } } while (0)

struct XcdBarrier {
    unsigned* bar; unsigned x;
    volatile LAS unsigned* st;
};

__device__ __forceinline__ XcdBarrier xcd_barrier_post(unsigned* bar, volatile LAS unsigned* st) {
    XcdBarrier b; b.bar = bar; b.x = xb_xcc_id(); b.st = st;
    if (threadIdx.x == 0) (void)xb_add(&bar[XB_XCNT(b.x)], 1u);
    return b;
}
__device__ __forceinline__ void xcd_barrier_complete(unsigned* bar, unsigned x, unsigned& nloc, unsigned& nx) {
    const unsigned G = gridDim.x * gridDim.y * gridDim.z;
    unsigned sum, cnt, mine, sp = 0u;
    for (;;) {
        sum = 0u; cnt = 0u; mine = 0u;
#pragma unroll
        for (unsigned j = 0; j < 16; ++j) { const unsigned c = xb_ld(&bar[XB_XCNT(j)]); sum += c; cnt += (c > 0u) ? 1u : 0u; mine = (j == x) ? c : mine; }
        if (sum == G) break;
        __builtin_amdgcn_s_sleep(1);
        if ((++sp & 255u) == 0u) { if (xb_ld(&bar[XB_TMO])) break; if (sp > XB_SPIN_CAP) { atomicAdd(&bar[XB_TMO], 1u); break; } }
    }
    nloc = mine > 0u ? mine : 1u; nx = cnt > 0u ? cnt : 1u;
}

__device__ __forceinline__ void xcd_barrier(const XcdBarrier& b) {
    asm volatile("s_waitcnt vmcnt(0)" ::: "memory");
    __syncthreads();
    if (threadIdx.x == 0) {
        unsigned* bar = b.bar;
        __builtin_amdgcn_s_waitcnt(0);
        unsigned nloc = b.st[0], nx = b.st[1];
        if (nloc == 0u) { xcd_barrier_complete(bar, b.x, nloc, nx); b.st[0] = nloc; b.st[1] = nx; }
        const unsigned old = xb_add(&bar[XB_XSUB(b.x)], 1u);
        const unsigned gen = old / nloc;
        if (old + 1u == (gen + 1u) * nloc) {
            __builtin_amdgcn_fence(__ATOMIC_RELEASE, "agent");
            asm volatile("s_waitcnt vmcnt(0)" ::: "memory");
            const unsigned og = xb_add(&bar[XB_TOP], 1u);
            const unsigned tg = og / nx;
            if (og + 1u == (tg + 1u) * nx) xb_add(&bar[XB_TOPGEN], 1u);
            else XB_SPIN(xb_ld(&bar[XB_TOPGEN]) == tg, bar);
            __builtin_amdgcn_fence(__ATOMIC_ACQUIRE, "agent");
            xb_add(&bar[XB_XGEN(b.x)], 1u);
            asm volatile("s_waitcnt vmcnt(0)" ::: "memory");
        } else {
            XB_SPIN(xb_ld(&bar[XB_XGEN(b.x)]) == gen, bar);
            __builtin_amdgcn_fence(__ATOMIC_ACQUIRE, "agent");
            asm volatile("s_waitcnt vmcnt(0)" ::: "memory");
        }
    }
    __syncthreads();
}

#define LAS __attribute__((address_space(3)))
typedef unsigned short bf16_t;
typedef short bf16x8 __attribute__((ext_vector_type(8)));
typedef float f32x4 __attribute__((ext_vector_type(4)));
typedef float f32x16 __attribute__((ext_vector_type(16)));
typedef unsigned u32x4 __attribute__((ext_vector_type(4)));
typedef unsigned u32x2 __attribute__((ext_vector_type(2)));
typedef float f32x2_t __attribute__((ext_vector_type(2)));
typedef __bf16 bf16x2_t __attribute__((ext_vector_type(2)));

constexpr int M = 32768, SEQ = 4096, DM = 1024, NB = 8;
constexpr int NWAVES = 8, NTHR = 512;
constexpr int LDS_BYTES = 147456;
constexpr float LN_EPS = 1e-5f;
constexpr float ALPHA = 1.4142135623730951f;
constexpr float LOG2E = 1.4426950408889634f;
constexpr float QSCALE = 0.125f * LOG2E;
constexpr float LAMBDA_INIT = 0.8f - 0.6f * 0.7408182206817179f;
constexpr int NPHASE = 17;
#ifndef REP_SYNC
#define REP_SYNC 1
#endif
#ifndef REP_P0
#define REP_P0 1
#endif
#ifndef REP_SSD
#define REP_SSD 1
#endif
#ifndef REP_ATTN
#define REP_ATTN 1
#endif
#ifndef REP_MIX
#define REP_MIX 1
#endif

constexpr size_t MiB = 1u << 20;
constexpr size_t WS_WIN = 1 * MiB, WS_WOUT0 = 11 * MiB, WS_WUP0 = 15 * MiB, WS_WDN0 = 23 * MiB, WS_WQK = 31 * MiB, WS_WV = 35 * MiB,
                 WS_WO1 = 37 * MiB, WS_WUP1 = 39 * MiB, WS_WDN1 = 47 * MiB, WS_SGUW = 55 * MiB;
constexpr size_t WS_XB = 64 * MiB;
constexpr size_t WS_BIG = 128 * MiB;
constexpr size_t WS_XBC = 384 * MiB;
constexpr size_t WS_DT = 480 * MiB;
constexpr size_t WS_END = 482 * MiB;

__device__ __forceinline__ unsigned pk2(float lo, float hi) { f32x2_t v = {lo, hi}; bf16x2_t b = __builtin_convertvector(v, bf16x2_t); return __builtin_bit_cast(unsigned, b); }
__device__ __forceinline__ float bflo(unsigned u) { return __uint_as_float(u << 16); }
__device__ __forceinline__ float bfhi(unsigned u) { return __uint_as_float(u & 0xffff0000u); }
__device__ __forceinline__ float bf2f(bf16_t h) { return __uint_as_float((unsigned)h << 16); }
__device__ __forceinline__ bf16_t f2bf(float f) { return (bf16_t)(pk2(f, 0.f) & 0xffffu); }
__device__ __forceinline__ float wave_sum(float v) {
#pragma unroll
    for (int o = 1; o < 64; o <<= 1) v += __shfl_xor(v, o);
    return v;
}
__device__ __forceinline__ float sigmoidf_(float x) { return 1.0f / (1.0f + __expf(-x)); }
#define MFMA16(a, b, c) __builtin_amdgcn_mfma_f32_16x16x32_bf16((a), (b), (c), 0, 0, 0)
#define MFMA32(a, b, c) __builtin_amdgcn_mfma_f32_32x32x16_bf16((a), (b), (c), 0, 0, 0)

__device__ __forceinline__ void tr_item(const float* W, int ld, int c0, bf16_t* WT, int K, int row0, float scale, LAS float* scr, int kb, int nb, int lane) {
    const int k0 = 64 * kb, n0 = 32 * nb;
#pragma unroll 8
    for (int i = 0; i < 32; ++i) { const int kk = 2 * i + (lane >> 5); scr[kk * 33 + (lane & 31)] = W[(size_t)(k0 + kk) * ld + c0 + n0 + (lane & 31)] * scale; }
    asm volatile("s_waitcnt lgkmcnt(0)" ::: "memory");
    const int c = lane & 7;
#pragma unroll
    for (int j = 0; j < 4; ++j) { const int n = (lane >> 3) + 8 * j; const LAS float* s = scr + (8 * c) * 33 + n;
        u32x4 o; o.x = pk2(s[0 * 33], s[1 * 33]); o.y = pk2(s[2 * 33], s[3 * 33]); o.z = pk2(s[4 * 33], s[5 * 33]); o.w = pk2(s[6 * 33], s[7 * 33]);
        *(u32x4*)(WT + (size_t)(row0 + n0 + n) * K + k0 + 8 * c) = o; }
    asm volatile("s_waitcnt lgkmcnt(0)" ::: "memory");
}
struct P0Args { const float *x, *w_in, *w_out0, *w_up, *w_dn, *w_qkv, *w_o1, *sgu_w; unsigned char* ws; };
__device__ __forceinline__ void p0_prologue(LAS unsigned char* lds, const P0Args& a, int G) {
    const int tid = threadIdx.x, lane = tid & 63, wid = __builtin_amdgcn_readfirstlane(tid >> 6);
    LAS float* scr = (LAS float*)(lds + wid * 16384);
    const int gw = blockIdx.x * NWAVES + wid, NGW = G * NWAVES;
    bf16_t* WIN = (bf16_t*)(a.ws + WS_WIN);
#define TR_MAT(src, ld, c0, ncols, dst, K, row0, scale) { const int nblk = (ncols) / 32, nit = ((K) / 64) * nblk; \
        if (r < nit) { tr_item((src), (ld), (c0), (dst), (K), (row0), (scale), scr, r / nblk, r % nblk, lane); continue; } r -= nit; }
    constexpr int NIT = 16 * 80 + 16 * 64 + 32 * 32 + 2 * (16 * 128) + 2 * (64 * 32) + 16 * 32 + 16 * 32 + 16 * 32 + 16 * 32;
    for (int it = gw; it < NIT; it += NGW) {
        int r = it;
        TR_MAT(a.w_in, 4624, 0, 2560, WIN, 1024, 0, 1.f)
        TR_MAT(a.w_in, 4624, 2576, 2048, WIN, 1024, 2560, 1.f)
        TR_MAT(a.w_out0, 1024, 0, 1024, (bf16_t*)(a.ws + WS_WOUT0), 2048, 0, 1.f)
        TR_MAT(a.w_up, 4096, 0, 4096, (bf16_t*)(a.ws + WS_WUP0), 1024, 0, 1.f)
        TR_MAT(a.w_up + (size_t)1024 * 4096, 4096, 0, 4096, (bf16_t*)(a.ws + WS_WUP1), 1024, 0, 1.f)
        TR_MAT(a.w_dn, 1024, 0, 1024, (bf16_t*)(a.ws + WS_WDN0), 4096, 0, 1.f)
        TR_MAT(a.w_dn + (size_t)4096 * 1024, 1024, 0, 1024, (bf16_t*)(a.ws + WS_WDN1), 4096, 0, 1.f)
        TR_MAT(a.w_qkv, 3072, 0, 1024, (bf16_t*)(a.ws + WS_WQK), 1024, 0, QSCALE)
        TR_MAT(a.w_qkv, 3072, 1024, 1024, (bf16_t*)(a.ws + WS_WQK), 1024, 1024, 1.f)
        TR_MAT(a.w_qkv, 3072, 2048, 1024, (bf16_t*)(a.ws + WS_WV), 1024, 0, 1.f)
        TR_MAT(a.w_o1, 1024, 0, 1024, (bf16_t*)(a.ws + WS_WO1), 1024, 0, 1.f)
    }
#undef TR_MAT
    const size_t gt = (size_t)blockIdx.x * NTHR + tid, NGT = (size_t)G * NTHR;
    for (size_t i = gt; i < (size_t)256 * 1024; i += NGT) { const int n = (int)(i >> 10), k = (int)(i & 1023);
        WIN[(size_t)(4608 + n) * 1024 + k] = n < 16 ? f2bf(a.w_in[(size_t)k * 4624 + 2560 + n]) : (bf16_t)0; }
    bf16_t* SW = (bf16_t*)(a.ws + WS_SGUW);
    for (size_t i = gt; i < (size_t)8 * 128 * 128; i += NGT) { const int s = (int)(i & 127), t = (int)((i >> 7) & 127);
        SW[i] = ((t >> 6) >= (s >> 6)) ? f2bf(a.sgu_w[i]) : (bf16_t)0; }
    bf16_t* XB = (bf16_t*)(a.ws + WS_XB);
    for (size_t i = gt; i < (size_t)M * DM / 8; i += NGT) { const f32x4 v0 = *(const f32x4*)(a.x + i * 8), v1 = *(const f32x4*)(a.x + i * 8 + 4);
        u32x4 o; o.x = pk2(v0[0], v0[1]); o.y = pk2(v0[2], v0[3]); o.z = pk2(v1[0], v1[1]); o.w = pk2(v1[2], v1[3]); *(u32x4*)(XB + i * 8) = o; }
}

__device__ __forceinline__ void ln_phase(float* buf, bf16_t* xb, const float* g, const float* b, int G) {
    const int tid = threadIdx.x, lane = tid & 63, wid = tid >> 6;
    const int gw = blockIdx.x * NWAVES + wid, NGW = G * NWAVES;
    f32x4 gv[4], bv[4];
#pragma unroll
    for (int j = 0; j < 4; ++j) { gv[j] = *(const f32x4*)(g + lane * 4 + 256 * j); bv[j] = *(const f32x4*)(b + lane * 4 + 256 * j); }
    for (int m = gw; m < M; m += NGW) {
        float* row = buf + (size_t)m * DM + lane * 4;
        f32x4 v[4]; float s = 0.f;
#pragma unroll
        for (int j = 0; j < 4; ++j) { v[j] = *(const f32x4*)(row + 256 * j); s += (v[j][0] + v[j][1]) + (v[j][2] + v[j][3]); }
        const float mean = wave_sum(s) * (1.f / DM); float s2 = 0.f;
#pragma unroll
        for (int j = 0; j < 4; ++j) { v[j] = v[j] - mean; s2 += (v[j][0] * v[j][0] + v[j][1] * v[j][1]) + (v[j][2] * v[j][2] + v[j][3] * v[j][3]); }
        const float rstd = 1.f / sqrtf(wave_sum(s2) * (1.f / DM) + LN_EPS);
        bf16_t* xr = xb + (size_t)m * DM + lane * 4;
#pragma unroll
        for (int j = 0; j < 4; ++j) { const f32x4 o = v[j] * rstd * gv[j] + bv[j]; *(f32x4*)(row + 256 * j) = o;
            u32x2 w; w.x = pk2(o[0], o[1]); w.y = pk2(o[2], o[3]); *(u32x2*)(xr + 256 * j) = w; }
    }
}

struct SsdArgs { const bf16_t* XBC; const float* DT; bf16_t* Y; const float *conv_w, *conv_b, *dt_bias, *a_log, *d_skip; };
__device__ __forceinline__ void ssd_load(u32x4 (&raw)[7], const bf16_t* XBC, int b, int c, int rr, int colg) {
#pragma unroll
    for (int i = 0; i < 7; ++i) { const int tr = c * 64 + 4 * rr - 3 + i;
        raw[i] = tr >= 0 ? *(const u32x4*)(XBC + (size_t)(b * SEQ + tr) * 1536 + colg) : (u32x4){0u, 0u, 0u, 0u}; }
}
__device__ __forceinline__ void ssd_conv_task(const u32x4 (&raw)[7], int cgi, int rr, const float (&wj)[4], LAS float* CW, LAS bf16_t* Bs, LAS bf16_t* Cs, LAS bf16_t* BsT,
                                              LAS bf16_t* xT, LAS bf16_t* xwT, LAS float* xs) {
    u32x4 pack[4];
#pragma unroll
    for (int ep = 0; ep < 4; ++ep) {
        float i0[7], i1[7];
#pragma unroll
        for (int i = 0; i < 7; ++i) { const unsigned u = raw[i][ep]; i0[i] = bflo(u); i1[i] = bfhi(u); }
        const int lc = cgi * 8 + 2 * ep;
        float w0[5], w1[5];
#pragma unroll
        for (int k = 0; k < 5; ++k) { w0[k] = CW[k * 288 + lc]; w1[k] = CW[k * 288 + lc + 1]; }
        float o0[4], o1[4];
#pragma unroll
        for (int j = 0; j < 4; ++j) { float a = w0[4], c = w1[4];
#pragma unroll
            for (int k = 0; k < 4; ++k) { a += w0[k] * i0[j + k]; c += w1[k] * i1[j + k]; }
            o0[j] = a * sigmoidf_(a); o1[j] = c * sigmoidf_(c); }
#pragma unroll
        for (int j = 0; j < 4; ++j) pack[j][ep] = pk2(o0[j], o1[j]);
        if (cgi < 4) {
            const int p = cgi * 8 + 2 * ep;
#pragma unroll
            for (int j = 0; j < 4; ++j) { xs[(4 * rr + j) * 33 + p] = o0[j]; xs[(4 * rr + j) * 33 + p + 1] = o1[j]; }
            *(LAS u32x2*)(xT + p * 72 + 4 * rr) = (u32x2){pk2(o0[0], o0[1]), pk2(o0[2], o0[3])};
            *(LAS u32x2*)(xT + (p + 1) * 72 + 4 * rr) = (u32x2){pk2(o1[0], o1[1]), pk2(o1[2], o1[3])};
            *(LAS u32x2*)(xwT + p * 72 + 4 * rr) = (u32x2){pk2(o0[0] * wj[0], o0[1] * wj[1]), pk2(o0[2] * wj[2], o0[3] * wj[3])};
            *(LAS u32x2*)(xwT + (p + 1) * 72 + 4 * rr) = (u32x2){pk2(o1[0] * wj[0], o1[1] * wj[1]), pk2(o1[2] * wj[2], o1[3] * wj[3])};
        } else if (cgi < 20) {
            const int n = (cgi - 4) * 8 + 2 * ep;
            *(LAS u32x2*)(BsT + n * 72 + 4 * rr) = (u32x2){pk2(o0[0], o0[1]), pk2(o0[2], o0[3])};
            *(LAS u32x2*)(BsT + (n + 1) * 72 + 4 * rr) = (u32x2){pk2(o1[0], o1[1]), pk2(o1[2], o1[3])};
        }
    }
    if (cgi >= 4 && cgi < 20) {
#pragma unroll
        for (int j = 0; j < 4; ++j) *(LAS u32x4*)(Bs + (4 * rr + j) * 136 + (cgi - 4) * 8) = pack[j];
    } else if (cgi >= 20) {
#pragma unroll
        for (int j = 0; j < 4; ++j) *(LAS u32x4*)(Cs + (4 * rr + j) * 136 + (cgi - 20) * 8) = pack[j];
    }
}
__device__ __forceinline__ void ssd_phase(LAS unsigned char* lds, const SsdArgs& A, int G) {
    const int tid = threadIdx.x, lane = tid & 63, wid = __builtin_amdgcn_readfirstlane(tid >> 6), l15 = lane & 15, quad = lane >> 4;
    LAS float* CW = (LAS float*)(lds);
    LAS float* DTS = (LAS float*)(lds + 6144);
    LAS bf16_t* Bs = (LAS bf16_t*)(lds + 8192);
    LAS bf16_t* Cs = Bs + 64 * 136;
    LAS bf16_t* BsT = Cs + 64 * 136;
    LAS bf16_t* xT = BsT + 128 * 72;
    LAS bf16_t* xwT = xT + 32 * 72;
    LAS bf16_t* Lm = xwT + 32 * 72;
    LAS bf16_t* St = Lm + 64 * 72;
    LAS float* xs = (LAS float*)(St + 32 * 136);
    for (int item = blockIdx.x; item < 256; item += G) {
        const int b = item >> 5, h = (item >> 1) & 15, ph = item & 1, g = h >> 3;
        __syncthreads();
        for (int idx = tid; idx < 5 * 288; idx += NTHR) { const int k = idx / 288, lc = idx % 288;
            const int col = lc < 32 ? h * 64 + ph * 32 + lc : (lc < 160 ? 1024 + g * 128 + (lc - 32) : 1280 + g * 128 + (lc - 160));
            CW[idx] = k < 4 ? A.conv_w[k * 1536 + col] : A.conv_b[col]; }
        for (int idx = tid; idx < 32 * 136 / 2; idx += NTHR) ((LAS unsigned*)St)[idx] = 0u;
        const float a_h = -__expf(A.a_log[h]), dtb = A.dt_bias[h], Dh = A.d_skip[h];
        const int cg0 = tid % 36, rr0 = tid / 36, cg1 = (tid + 512) % 36, rr1 = (tid + 512) / 36;
        const int colg0 = cg0 < 4 ? h * 64 + ph * 32 + cg0 * 8 : (cg0 < 20 ? 1024 + g * 128 + (cg0 - 4) * 8 : 1280 + g * 128 + (cg0 - 20) * 8);
        const int colg1 = cg1 < 4 ? h * 64 + ph * 32 + cg1 * 8 : (cg1 < 20 ? 1024 + g * 128 + (cg1 - 4) * 8 : 1280 + g * 128 + (cg1 - 20) * 8);
        u32x4 raw0[7], raw1[7]; float dtraw;
        ssd_load(raw0, A.XBC, b, 0, rr0, colg0);
        if (tid < 64) ssd_load(raw1, A.XBC, b, 0, rr1, colg1);
        dtraw = A.DT[(size_t)(b * SEQ + lane) * 16 + h];
        f32x4 state[2]; state[0] = (f32x4){0.f, 0.f, 0.f, 0.f}; state[1] = (f32x4){0.f, 0.f, 0.f, 0.f};
        __syncthreads();
        for (int c = 0; c < 64; ++c) {
            const int rowbase = b * SEQ + c * 64;
            const float xdt = dtraw + dtb; const float dtv = xdt > 20.f ? xdt : log1pf(__expf(xdt));
            float acs = dtv * a_h;
#pragma unroll
            for (int off = 1; off < 64; off <<= 1) { const float t = __shfl_up(acs, off); if (lane >= off) acs += t; }
            const float acs63 = __shfl(acs, 63);
            const float wl = dtv * __expf(acs63 - acs);
            if (wid == 0) { DTS[lane] = dtv; DTS[64 + lane] = acs; DTS[128 + lane] = __expf(acs); }
            float wj0[4], wj1[4];
#pragma unroll
            for (int j = 0; j < 4; ++j) { wj0[j] = __shfl(wl, (4 * rr0 + j) & 63); wj1[j] = __shfl(wl, (4 * rr1 + j) & 63); }
            ssd_conv_task(raw0, cg0, rr0, wj0, CW, Bs, Cs, BsT, xT, xwT, xs);
            if (tid < 64) ssd_conv_task(raw1, cg1, rr1, wj1, CW, Bs, Cs, BsT, xT, xwT, xs);
            __syncthreads();
            if (c < 63) { ssd_load(raw0, A.XBC, b, c + 1, rr0, colg0); if (tid < 64) ssd_load(raw1, A.XBC, b, c + 1, rr1, colg1);
                dtraw = A.DT[(size_t)(rowbase + 64 + lane) * 16 + h]; }
            { const int ti = wid & 3, sjb = (wid >> 2) * 2;
#pragma unroll
              for (int q = 0; q < 2; ++q) { const int sj = sjb + q; f32x4 acc = (f32x4){0.f, 0.f, 0.f, 0.f};
                if (sj <= ti) {
#pragma unroll
                    for (int kk = 0; kk < 4; ++kk) { const bf16x8 av = *(const LAS bf16x8*)(Cs + (16 * ti + l15) * 136 + kk * 32 + quad * 8);
                        const bf16x8 bv = *(const LAS bf16x8*)(Bs + (16 * sj + l15) * 136 + kk * 32 + quad * 8); acc = MFMA16(av, bv, acc); }
                }
                const int s = 16 * sj + l15; const float acs_s = DTS[64 + s], dt_s = DTS[s];
#pragma unroll
                for (int r = 0; r < 4; ++r) { const int t = 16 * ti + 4 * quad + r; const float acs_t = DTS[64 + t];
                    const float v = (s <= t) ? acc[r] * __expf(acs_t - acs_s) * dt_s : 0.f; Lm[t * 72 + s] = f2bf(v); } } }
            __syncthreads();
            { const int ti = wid & 3, pj = wid >> 2; f32x4 accd = (f32x4){0.f, 0.f, 0.f, 0.f}, acco = (f32x4){0.f, 0.f, 0.f, 0.f};
#pragma unroll
              for (int kk = 0; kk < 2; ++kk) { const bf16x8 av = *(const LAS bf16x8*)(Lm + (16 * ti + l15) * 72 + kk * 32 + quad * 8);
                  const bf16x8 bv = *(const LAS bf16x8*)(xT + (16 * pj + l15) * 72 + kk * 32 + quad * 8); accd = MFMA16(av, bv, accd); }
#pragma unroll
              for (int kk = 0; kk < 4; ++kk) { const bf16x8 av = *(const LAS bf16x8*)(Cs + (16 * ti + l15) * 136 + kk * 32 + quad * 8);
                  const bf16x8 bv = *(const LAS bf16x8*)(St + (16 * pj + l15) * 136 + kk * 32 + quad * 8); acco = MFMA16(av, bv, acco); }
              const int p = 16 * pj + l15;
#pragma unroll
              for (int r = 0; r < 4; ++r) { const int t = 16 * ti + 4 * quad + r; const float y = accd[r] + DTS[128 + t] * acco[r] + Dh * xs[t * 33 + p];
                  A.Y[(size_t)(rowbase + t) * 1024 + h * 64 + ph * 32 + p] = f2bf(y); } }
            const int pi = wid & 1, njb = (wid >> 1) * 2; const float dec = __expf(acs63);
#pragma unroll
            for (int q = 0; q < 2; ++q) { const int nj = njb + q; f32x4 acc = (f32x4){0.f, 0.f, 0.f, 0.f};
#pragma unroll
                for (int kk = 0; kk < 2; ++kk) { const bf16x8 av = *(const LAS bf16x8*)(xwT + (16 * pi + l15) * 72 + kk * 32 + quad * 8);
                    const bf16x8 bv = *(const LAS bf16x8*)(BsT + (16 * nj + l15) * 72 + kk * 32 + quad * 8); acc = MFMA16(av, bv, acc); }
                state[q] = state[q] * dec + acc; }
            __syncthreads();
#pragma unroll
            for (int q = 0; q < 2; ++q)
#pragma unroll
                for (int r = 0; r < 4; ++r) St[(16 * pi + 4 * quad + r) * 136 + 16 * (njb + q) + l15] = f2bf(state[q][r]);
        }
    }
}

struct MixArgs { const bf16_t *Y, *Z, *UV, *SW; bf16_t* MIX; const float *norm_w, *ln_g, *ln_b, *sgu_b; };
__device__ __forceinline__ void mix_phase(LAS unsigned char* lds, const MixArgs& A, int G) {
    const int tid = threadIdx.x, lane = tid & 63, wid = __builtin_amdgcn_readfirstlane(tid >> 6), l15 = lane & 15, quad = lane >> 4;
    LAS float* stats = (LAS float*)lds;
    LAS bf16_t* VnT0 = (LAS bf16_t*)(lds + 1024);
    for (int u = blockIdx.x; u < M / 128; u += G) {
        const int m0 = u * 128;
        __syncthreads();
        for (int rr = wid; rr < 128; rr += NWAVES) {
            const size_t m = (size_t)(m0 + rr);
#pragma unroll
            for (int gi = 0; gi < 2; ++gi) {
                const int col = gi * 512 + lane * 8;
                const u32x4 yv = *(const u32x4*)(A.Y + m * 1024 + col), zv = *(const u32x4*)(A.Z + m * 1024 + col);
                float v[8]; float ss = 0.f;
#pragma unroll
                for (int e = 0; e < 4; ++e) { const float z0 = bflo(zv[e]), z1 = bfhi(zv[e]); v[2 * e] = bflo(yv[e]) * z0 * sigmoidf_(z0); v[2 * e + 1] = bfhi(yv[e]) * z1 * sigmoidf_(z1);
                    ss += v[2 * e] * v[2 * e] + v[2 * e + 1] * v[2 * e + 1]; }
                const float rs = 1.f / sqrtf(wave_sum(ss) * (1.f / 512.f) + LN_EPS);
                const f32x4 w0 = *(const f32x4*)(A.norm_w + col), w1 = *(const f32x4*)(A.norm_w + col + 4);
                u32x4 o; o.x = pk2(v[0] * rs * w0[0], v[1] * rs * w0[1]); o.y = pk2(v[2] * rs * w0[2], v[3] * rs * w0[3]);
                o.z = pk2(v[4] * rs * w1[0], v[5] * rs * w1[1]); o.w = pk2(v[6] * rs * w1[2], v[7] * rs * w1[3]);
                *(u32x4*)(A.MIX + m * 2048 + col) = o;
            }
            { const bf16_t* vr = A.UV + m * 2048 + 1024;
              const u32x4 a0 = *(const u32x4*)(vr + lane * 8), a1 = *(const u32x4*)(vr + 512 + lane * 8);
              float v[16]; float s = 0.f;
#pragma unroll
              for (int e = 0; e < 4; ++e) { v[2 * e] = bflo(a0[e]); v[2 * e + 1] = bfhi(a0[e]); v[8 + 2 * e] = bflo(a1[e]); v[8 + 2 * e + 1] = bfhi(a1[e]); }
#pragma unroll
              for (int e = 0; e < 16; ++e) s += v[e];
              const float mean = wave_sum(s) * (1.f / 1024.f); float s2 = 0.f;
#pragma unroll
              for (int e = 0; e < 16; ++e) { const float d = v[e] - mean; s2 += d * d; }
              const float rstd = 1.f / sqrtf(wave_sum(s2) * (1.f / 1024.f) + LN_EPS);
              if (lane == 0) { stats[2 * rr] = mean; stats[2 * rr + 1] = rstd; } }
        }
        __syncthreads();
        for (int gi = 0; gi < 8; ++gi) {
            LAS bf16_t* buf = VnT0 + (gi & 1) * (128 * 136);
#pragma unroll
            for (int i = 0; i < 4; ++i) { const int task = tid + NTHR * i, s = task & 127, cgp = task >> 7;
                const u32x4 vv = *(const u32x4*)(A.UV + (size_t)(m0 + s) * 2048 + 1024 + gi * 128 + cgp * 8);
                const float mean = stats[2 * s], rstd = stats[2 * s + 1];
                const f32x4 g0 = *(const f32x4*)(A.ln_g + gi * 128 + cgp * 8), g1 = *(const f32x4*)(A.ln_g + gi * 128 + cgp * 8 + 4);
                const f32x4 b0 = *(const f32x4*)(A.ln_b + gi * 128 + cgp * 8), b1 = *(const f32x4*)(A.ln_b + gi * 128 + cgp * 8 + 4);
#pragma unroll
                for (int e = 0; e < 4; ++e) { const float gA = e < 2 ? g0[2 * e] : g1[2 * e - 4], gB = e < 2 ? g0[2 * e + 1] : g1[2 * e - 3];
                    const float bA = e < 2 ? b0[2 * e] : b1[2 * e - 4], bB = e < 2 ? b0[2 * e + 1] : b1[2 * e - 3];
                    buf[(cgp * 8 + 2 * e) * 136 + s] = f2bf((bflo(vv[e]) - mean) * rstd * gA + bA);
                    buf[(cgp * 8 + 2 * e + 1) * 136 + s] = f2bf((bfhi(vv[e]) - mean) * rstd * gB + bB); } }
            __syncthreads();
            bf16x8 af[4];
#pragma unroll
            for (int kk = 0; kk < 4; ++kk) af[kk] = *(const bf16x8*)(A.SW + (size_t)gi * 16384 + (16 * wid + l15) * 128 + kk * 32 + quad * 8);
            float bias[4];
#pragma unroll
            for (int r = 0; r < 4; ++r) bias[r] = A.sgu_b[gi * 128 + 16 * wid + 4 * quad + r];
#pragma unroll 2
            for (int cj = 0; cj < 8; ++cj) { f32x4 acc = (f32x4){0.f, 0.f, 0.f, 0.f};
#pragma unroll
                for (int kk = 0; kk < 4; ++kk) { const bf16x8 bv = *(const LAS bf16x8*)(buf + (16 * cj + l15) * 136 + kk * 32 + quad * 8); acc = MFMA16(af[kk], bv, acc); }
#pragma unroll
                for (int r = 0; r < 4; ++r) { const size_t m = (size_t)(m0 + 16 * wid + 4 * quad + r); const int c = gi * 128 + 16 * cj + l15;
                    const float uval = bf2f(A.UV[m * 2048 + c]); A.MIX[m * 2048 + 1024 + c] = f2bf(uval * (acc[r] + bias[r])); } }
        }
    }
}

struct AttnArgs { const bf16_t *QK, *VT; bf16_t* AO; const float *lq1, *lk1, *lq2, *lk2, *subw; };
__device__ __forceinline__ int crow(int i, int hh) { return (i & 3) + 8 * (i >> 2) + 4 * hh; }
__device__ __forceinline__ void attn_phase(LAS unsigned char* lds, const AttnArgs& A, int G) {
    const int tid = threadIdx.x, lane = tid & 63, wid = __builtin_amdgcn_readfirstlane(tid >> 6), r = lane & 31, hh = lane >> 5;
    const int map = wid & 1, rg = wid >> 1;
    const float lam = __expf(wave_sum(A.lq1[lane] * A.lk1[lane])) - __expf(wave_sum(A.lq2[lane] * A.lk2[lane])) + LAMBDA_INIT;
    LAS bf16_t* Kbuf = (LAS bf16_t*)lds;
    LAS bf16_t* Vbuf = (LAS bf16_t*)(lds + 34816);
    LAS float* wsf = (LAS float*)(lds + 71680) + wid * 64;
    LAS float* XCH = (LAS float*)lds + rg * 4096;
    for (int vb = blockIdx.x; vb < 256; vb += G) {
        const int bh = vb >> 2, b = bh >> 3, h = bh & 7, sx = vb & 3;
        const float slope2 = exp2f(-(float)(h + 1)) * LOG2E;
        const int rowb = b * SEQ;
        for (int ui = 0; ui < 8; ++ui) {
            const int qb = (ui & 1) ? 8 * (ui >> 1) + 7 - sx : 8 * (ui >> 1) + sx;
            const int q0 = qb * 128, qc = 2 * qb + (rg >> 1), T0 = 2 * qb + 1;
            bf16x8 qf[4];
#pragma unroll
            for (int s = 0; s < 4; ++s) qf[s] = *(const bf16x8*)(A.QK + (size_t)(rowb + q0 + 32 * rg + r) * 2048 + h * 128 + map * 64 + 16 * s + 8 * hh);
            f32x16 O[4];
#pragma unroll
            for (int db = 0; db < 4; ++db)
#pragma unroll
                for (int i = 0; i < 16; ++i) O[db][i] = 0.f;
            float m_run = -1e30f, l_run = 0.f;
            const int krow0 = tid >> 4, kcp = tid & 15, vd0 = tid >> 3, vcp = tid & 7;
            const bf16_t* ksrc = A.QK + (size_t)(rowb + krow0) * 2048 + 1024 + h * 128 + kcp * 8;
            const bf16_t* vsrc = A.VT + (size_t)(h * 128 + vd0) * M + rowb + vcp * 8;
            u32x4 kr0, kr1, vr0, vr1;
#define ATT_LOAD(kt) do { kr0 = *(const u32x4*)(ksrc + (size_t)((kt) * 64) * 2048); kr1 = *(const u32x4*)(ksrc + (size_t)((kt) * 64 + 32) * 2048); \
                          vr0 = *(const u32x4*)(vsrc + (kt) * 64); vr1 = *(const u32x4*)(vsrc + (size_t)64 * M + (kt) * 64); } while (0)
#define ATT_WRITE(bufi) do { *(LAS u32x4*)(Kbuf + (bufi) * (64 * 136) + krow0 * 136 + kcp * 8) = kr0; *(LAS u32x4*)(Kbuf + (bufi) * (64 * 136) + (krow0 + 32) * 136 + kcp * 8) = kr1; \
                             *(LAS u32x4*)(Vbuf + (bufi) * (128 * 72) + vd0 * 72 + vcp * 8) = vr0; *(LAS u32x4*)(Vbuf + (bufi) * (128 * 72) + (vd0 + 64) * 72 + vcp * 8) = vr1; } while (0)
            __syncthreads();
            ATT_LOAD(T0); ATT_WRITE(0);
            __syncthreads();
            int cur = 0;
            for (int kt = T0; kt >= 0; --kt) {
                if (kt > 0) ATT_LOAD(kt - 1);
                if (kt <= qc) {
                    const LAS bf16_t* Kb = Kbuf + cur * (64 * 136); const LAS bf16_t* Vb = Vbuf + cur * (128 * 72);
                    f32x16 sv[2];
#pragma unroll
                    for (int kb = 0; kb < 2; ++kb) {
#pragma unroll
                        for (int i = 0; i < 16; ++i) sv[kb][i] = 0.f;
#pragma unroll
                        for (int s = 0; s < 4; ++s) { const bf16x8 av = *(const LAS bf16x8*)(Kb + (32 * kb + r) * 136 + map * 64 + 16 * s + 8 * hh); sv[kb] = MFMA32(av, qf[s], sv[kb]); }
                    }
                    const float basef = (float)(q0 + 32 * rg + r - kt * 64 - 4 * hh);
                    float mx = -1e30f;
#pragma unroll
                    for (int kb = 0; kb < 2; ++kb)
#pragma unroll
                        for (int i = 0; i < 16; ++i) { const float cst = (float)(32 * kb + (i & 3) + 8 * (i >> 2)); const float v = sv[kb][i] - slope2 * fabsf(basef - cst); sv[kb][i] = v; mx = fmaxf(mx, v); }
                    mx = fmaxf(mx, __shfl_xor(mx, 32));
                    const float m_new = fmaxf(m_run, mx);
                    if (__any(m_new > m_run)) {
                        const float alpha = exp2f(m_run - m_new); l_run *= alpha; m_run = m_new;
                        if (hh == 0) wsf[r] = alpha;
#pragma unroll
                        for (int i = 0; i < 16; ++i) { const float al = wsf[crow(i, hh)];
#pragma unroll
                            for (int db = 0; db < 4; ++db) O[db][i] *= al; }
                    }
                    float ps = 0.f;
#pragma unroll
                    for (int kb = 0; kb < 2; ++kb)
#pragma unroll
                        for (int i = 0; i < 16; ++i) { const float p = exp2f(sv[kb][i] - m_run); sv[kb][i] = p; ps += p; }
                    l_run += ps;
#pragma unroll
                    for (int s2 = 0; s2 < 4; ++s2) { const int kb = s2 >> 1, hf = s2 & 1;
                        u32x4 pw; pw.x = pk2(sv[kb][8 * hf + 0], sv[kb][8 * hf + 1]); pw.y = pk2(sv[kb][8 * hf + 2], sv[kb][8 * hf + 3]);
                        pw.z = pk2(sv[kb][8 * hf + 4], sv[kb][8 * hf + 5]); pw.w = pk2(sv[kb][8 * hf + 6], sv[kb][8 * hf + 7]);
                        const bf16x8 pa = __builtin_bit_cast(bf16x8, pw);
#pragma unroll
                        for (int db = 0; db < 4; ++db) { const LAS bf16_t* vp = Vb + (32 * db + r) * 72 + 32 * kb + 16 * hf + 4 * hh;
                            const u32x2 lo = *(const LAS u32x2*)(vp), hi = *(const LAS u32x2*)(vp + 8);
                            u32x4 vw; vw.x = lo.x; vw.y = lo.y; vw.z = hi.x; vw.w = hi.y;
                            O[db] = MFMA32(pa, __builtin_bit_cast(bf16x8, vw), O[db]); } }
                }
                if (kt > 0) ATT_WRITE(cur ^ 1);
                __syncthreads();
                cur ^= 1;
            }
#undef ATT_LOAD
#undef ATT_WRITE
            const float l_tot = l_run + __shfl_xor(l_run, 32);
            if (hh == 0) wsf[32 + r] = 1.f / l_tot;
#pragma unroll
            for (int i = 0; i < 16; ++i) { const float li = wsf[32 + crow(i, hh)];
#pragma unroll
                for (int db = 0; db < 4; ++db) O[db][i] *= li; }
            if (map == 1) {
#pragma unroll
                for (int db = 0; db < 4; ++db)
#pragma unroll
                    for (int i = 0; i < 16; ++i) XCH[(db * 16 + i) * 64 + lane] = O[db][i];
            }
            __syncthreads();
            if (map == 0) {
                float ss[16];
#pragma unroll
                for (int i = 0; i < 16; ++i) { float a = 0.f;
#pragma unroll
                    for (int db = 0; db < 4; ++db) { const float o = O[db][i] - lam * XCH[(db * 16 + i) * 64 + lane]; O[db][i] = o; a += o * o; }
                    ss[i] = a; }
#pragma unroll
                for (int i = 0; i < 16; ++i) {
#pragma unroll
                    for (int o = 1; o < 32; o <<= 1) ss[i] += __shfl_xor(ss[i], o);
                    ss[i] = (1.f - LAMBDA_INIT) / sqrtf(ss[i] * (1.f / 128.f) + LN_EPS); }
#pragma unroll
                for (int db = 0; db < 4; ++db) { const float w = A.subw[32 * db + r];
#pragma unroll
                    for (int i = 0; i < 16; ++i) A.AO[(size_t)(rowb + q0 + 32 * rg + crow(i, hh)) * 1024 + h * 128 + 32 * db + r] = f2bf(O[db][i] * ss[i] * w); }
            }
        }
    }
}

struct Args { const float* in[26]; float* out; unsigned char* ws; int ph_lo, ph_hi; };
__global__ void __launch_bounds__(NTHR, 2) mega_fwd(Args args) {
    extern __shared__ __attribute__((aligned(16))) unsigned char lds_raw[];
    LAS unsigned char* lds = (LAS unsigned char*)lds_raw;
    cg::grid_group grid = cg::this_grid();
    const int G = gridDim.x;
    unsigned char* ws = args.ws;
    float* out = args.out;
    bf16_t* XB = (bf16_t*)(ws + WS_XB);
    bf16_t* MIX = (bf16_t*)(ws + WS_BIG);
    bf16_t* UV = (bf16_t*)(ws + WS_BIG + 128 * MiB);
    bf16_t* FF = (bf16_t*)(ws + WS_BIG);
    bf16_t* QK = (bf16_t*)(ws + WS_BIG);
    bf16_t* VT = (bf16_t*)(ws + WS_BIG + 128 * MiB);
    bf16_t* AO = (bf16_t*)(ws + WS_BIG + 192 * MiB);
    bf16_t* XBC = (bf16_t*)(ws + WS_XBC);
    float* DT = (float*)(ws + WS_DT);
    bf16_t* Zb = (bf16_t*)out;
    bf16_t* Yb = (bf16_t*)out + (size_t)M * 1024;
    const int lo = args.ph_lo, hi = args.ph_hi;
    if (threadIdx.x < 4) ((LAS unsigned*)(lds + LDS_BYTES - 16))[threadIdx.x] = 0u;
    __syncthreads();
    const XcdBarrier xbar = xcd_barrier_post((unsigned*)ws, (volatile LAS unsigned*)(lds + LDS_BYTES - 16));
#ifndef ONLY
#define EN(k) 1
#else
#define EN(k) ((ONLY)==(k))
#endif
#define IN(k) (EN(k) && lo <= (k) && (k) < hi)
#define SEAM(k) do { if ((k) + 1 < hi) { for (int rs_ = 0; rs_ < REP_SYNC; ++rs_) { if ((k) == 0) grid.sync(); else xcd_barrier(xbar); } } } while (0)
#define GEMM_RES(k, Aop, Wt, Kdim, rbase) if (IN(k)) { pg8::Gemm g{(Aop), (const bf16_t*)(ws + (Wt)), M, 1024, (Kdim)}; pg8::StaticOrder S; S.init(M, 1024, G, (int)blockIdx.x); \
        pg8::EpiRes E{(rbase), out, ALPHA}; pg8::gemm_phase<pg8::EpiRes, pg8::StaticOrder, true, true>(lds, g, S, E); SEAM(k); }
#define GEMM_UP(k, Wt) if (IN(k)) { pg8::Gemm g{XB, (const bf16_t*)(ws + (Wt)), M, 4096, 1024}; pg8::StaticOrder S; S.init(M, 4096, G, (int)blockIdx.x); \
        pg8::EpiPlain<2> E{FF, 4096}; pg8::gemm_phase<pg8::EpiPlain<2>, pg8::StaticOrder, true, true>(lds, g, S, E); SEAM(k); }
#define LNPH(k, gi, bi, l) if (IN(k)) { ln_phase(out, XB, args.in[gi] + (l) * 1024, args.in[bi] + (l) * 1024, G); SEAM(k); }
    if (IN(0)) { P0Args a{args.in[0], args.in[1], args.in[12], args.in[24], args.in[25], args.in[13], args.in[19], args.in[10], ws}; for (int rep = 0; rep < REP_P0; ++rep) p0_prologue(lds, a, G); SEAM(0); }
    if (IN(1)) { pg8::Gemm g{XB, (const bf16_t*)(ws + WS_WIN), M, 4864, 1024}; pg8::StaticOrder S; S.init(M, 4864, G, (int)blockIdx.x);
                 pg8::EpiInProj E{Zb, XBC, UV, DT}; pg8::gemm_phase<pg8::EpiInProj, pg8::StaticOrder, true, true>(lds, g, S, E); SEAM(1); }
    if (IN(2)) { SsdArgs a{XBC, DT, Yb, args.in[2], args.in[3], args.in[4], args.in[5], args.in[6]}; for (int rep = 0; rep < REP_SSD; ++rep) ssd_phase(lds, a, G); SEAM(2); }
    if (IN(3)) { MixArgs a{Yb, Zb, UV, (const bf16_t*)(ws + WS_SGUW), MIX, args.in[7], args.in[8], args.in[9], args.in[11]}; for (int rep = 0; rep < REP_MIX; ++rep) mix_phase(lds, a, G); SEAM(3); }
    GEMM_RES(4, MIX, WS_WOUT0, 2048, args.in[0])
    LNPH(5, 20, 21, 0)
    GEMM_UP(6, WS_WUP0)
    GEMM_RES(7, FF, WS_WDN0, 4096, out)
    LNPH(8, 22, 23, 0)
    if (IN(9)) { pg8::Gemm g{XB, (const bf16_t*)(ws + WS_WQK), M, 2048, 1024}; pg8::StaticOrder S; S.init(M, 2048, G, (int)blockIdx.x);
                 pg8::EpiPlain<0> E{QK, 2048}; pg8::gemm_phase<pg8::EpiPlain<0>, pg8::StaticOrder, true, true>(lds, g, S, E); SEAM(9); }
    if (IN(10)) { pg8::Gemm g{(const bf16_t*)(ws + WS_WV), XB, 1024, M, 1024}; pg8::StaticOrder S; S.init(1024, M, G, (int)blockIdx.x);
                 pg8::EpiPlain<0> E{VT, M}; pg8::gemm_phase<pg8::EpiPlain<0>, pg8::StaticOrder, true, true>(lds, g, S, E); SEAM(10); }
    if (IN(11)) { AttnArgs a{QK, VT, AO, args.in[14], args.in[15], args.in[16], args.in[17], args.in[18]}; for (int rep = 0; rep < REP_ATTN; ++rep) attn_phase(lds, a, G); SEAM(11); }
    GEMM_RES(12, AO, WS_WO1, 1024, out)
    LNPH(13, 20, 21, 1)
    GEMM_UP(14, WS_WUP1)
    GEMM_RES(15, FF, WS_WDN1, 4096, out)
    LNPH(16, 22, 23, 1)
}

extern "C" void kernel_launch(void* const* d_in, const int* in_sizes, int n_in, void* d_out, int out_size, void* d_ws, size_t ws_size, hipStream_t stream) {
    static int grid = 0;
    if (grid == 0) {
        if (n_in != 26 || out_size != M * DM || ws_size < WS_END) { fprintf(stderr, "kernel_launch: unexpected shapes (n_in %d out %d ws %zu)\n", n_in, out_size, ws_size); grid = -1; return; }
        int dev = 0, cus = 0, per_cu = 0;
        hipGetDevice(&dev); hipDeviceGetAttribute(&cus, hipDeviceAttributeMultiprocessorCount, dev);
        if (hipFuncSetAttribute((const void*)mega_fwd, hipFuncAttributeMaxDynamicSharedMemorySize, LDS_BYTES) != hipSuccess) { fprintf(stderr, "kernel_launch: hipFuncSetAttribute failed\n"); grid = -1; return; }
        if (hipOccupancyMaxActiveBlocksPerMultiprocessor(&per_cu, (const void*)mega_fwd, NTHR, LDS_BYTES) != hipSuccess || per_cu < 1) { fprintf(stderr, "kernel_launch: occupancy query gives %d\n", per_cu); per_cu = 1; }
        (void)hipGetLastError();
        grid = cus * (per_cu > 1 ? 1 : per_cu);
        if (grid <= 0) grid = 256;
    }
    if (grid < 0) return;
    Args a{};
    for (int i = 0; i < 26; ++i) a.in[i] = (const float*)d_in[i];
    a.out = (float*)d_out; a.ws = (unsigned char*)d_ws; a.ph_lo = 0; a.ph_hi = NPHASE;
    if (hipMemsetAsync(d_ws, 0, 16384, stream) != hipSuccess) { fprintf(stderr, "kernel_launch: memset failed\n"); return; }
    void* kargs[] = {&a};
    hipError_t e = hipLaunchCooperativeKernel((const void*)mega_fwd, dim3(grid), dim3(NTHR), kargs, LDS_BYTES, stream);
    if (e != hipSuccess) fprintf(stderr, "kernel_launch: cooperative launch failed: %s (grid %d)\n", hipGetErrorString(e), grid);
}
```

```cpp
#include <hip/hip_runtime.h>
#include <hip/hip_cooperative_groups.h>
#include <cstdio>
#include <cstdint>
namespace cg = cooperative_groups;
#define LAS __attribute__((address_space(3)))
namespace pg8 {
#define PG8_LAS __attribute__((address_space(3)))
typedef unsigned short bf16_t;
typedef short bf16x8 __attribute__((ext_vector_type(8)));
typedef float f32x4 __attribute__((ext_vector_type(4)));
typedef unsigned u32x4 __attribute__((ext_vector_type(4)));
constexpr int BM = 256, BK = 64, HALF = 128, HTB = HALF * BK * 2  , STAGE_BYTES = 8 * HTB, NXCD = 8, WGM = 8;

__host__ __device__ __forceinline__ int lds_byte(int r, int c) { const int st = (r >> 4) * 2 + (c >> 5), rr = r & 15, cc = c & 31, ob = rr * 64 + cc * 2; return st * 1024 + (ob ^ (((ob >> 9) & 1) << 5)); }
__host__ __device__ __forceinline__ void stage_rc(int b, int& R, int& C) { const int st = b / 1024, sb = b % 1024, swz = sb ^ (((sb >> 9) & 1) << 5); R = (st >> 1) * 16 + swz / 64; C = (st & 1) * 32 + (swz % 64) / 2; }
__host__ __device__ __forceinline__ int perm32(int rho) { const int n = rho >> 4, i = rho & 15; return 8 * (i >> 2) + 4 * n + (i & 3); }

struct Unit { int pm, pn; };
struct Gemm { const bf16_t* A; const bf16_t* Bt; int M, N, K; };

struct StaticOrder {
    int nM, nN, nwg, G, c;
    __host__ __device__ void init(int M, int N, int G_, int c_) { nM = M / BM; nN = N / BM; nwg = nM * nN; G = G_; c = c_; }
    __host__ __device__ bool next(int i, Unit& u) const {
        const long L = (long)i * G + c; if (L >= nwg) return false;
        int wgid = (int)L; { const int q = nwg / NXCD, r = nwg % NXCD, xcd = wgid % NXCD, off = wgid / NXCD; wgid = (xcd < r ? xcd * (q + 1) : r * (q + 1) + (xcd - r) * q) + off; }
        const int nig = WGM * nN, gid = wgid / nig, fm = gid * WGM, gsz = (nM - fm) < WGM ? (nM - fm) : WGM;
        u.pm = fm + ((wgid % nig) % gsz); u.pn = (wgid % nig) / gsz; return true;
    }
    __device__ __forceinline__ void a_ready(const Unit&) const {}
    __device__ __forceinline__ void done(const Unit&) const {}
};
__device__ __forceinline__ unsigned cvt_pk_bf16(float lo, float hi) { unsigned r; asm volatile("v_cvt_pk_bf16_f32 %0, %1, %2" : "=v"(r) : "v"(lo), "v"(hi)); return r; }
typedef float f32x2 __attribute__((ext_vector_type(2)));
__device__ __forceinline__ f32x2 gelu_pk(f32x2 v) {
    const f32x2 av = __builtin_elementwise_abs(v), d = av * 0.2316418882f + 1.0f;
    f32x2 t; t.x = __builtin_amdgcn_rcpf(d.x); t.y = __builtin_amdgcn_rcpf(d.y);
    f32x2 q = t * 0.5307027145f + (-0.7265760135f); q = q * t + 0.7107068705f; q = q * t + (-0.142248368f); q = q * t + 0.127414796f; q = q * t;
    const f32x2 s = (v * v) * (-0.72134752044f);
    f32x2 e; e.x = __builtin_amdgcn_exp2f(s.x); e.y = __builtin_amdgcn_exp2f(s.y);
    const f32x2 m = v * (q * e), r = v - m;
    f32x2 o; o.x = v.x < 0.f ? m.x : r.x; o.y = v.y < 0.f ? m.y : r.y; return o;
}
typedef unsigned u32x4e __attribute__((ext_vector_type(4)));
template <int ACT  > struct EpiPlain {
    static constexpr bool PERM = true, AFTER_DRAIN = false;
    bf16_t* O; int ldc;
    __device__ __forceinline__ void operator()(const f32x4 (&acc)[2][2][4][2], const Unit& u, int wr, int wc, int fr, int fq) const {
        const int row0 = u.pm * BM + wr * 64 + fr, col0 = u.pn * BM + wc * 32 + 8 * fq;
#pragma unroll
        for (int ai = 0; ai < 2; ++ai)
#pragma unroll
            for (int m = 0; m < 4; ++m) { bf16_t* rowp = O + (size_t)(row0 + ai * HALF + m * 16) * ldc + col0;
#pragma unroll
                for (int bj = 0; bj < 2; ++bj) { f32x4 v0 = acc[ai][bj][m][0], v1 = acc[ai][bj][m][1];
                    if (ACT == 2) {
#pragma unroll
                        for (int e = 0; e < 4; ++e) { const float a = v0[e] > 0.f ? v0[e] : 0.f, b = v1[e] > 0.f ? v1[e] : 0.f; v0[e] = a * a; v1[e] = b * b; } }
                    u32x4e w; w.x = cvt_pk_bf16(v0[0], v0[1]); w.y = cvt_pk_bf16(v0[2], v0[3]); w.z = cvt_pk_bf16(v1[0], v1[1]); w.w = cvt_pk_bf16(v1[2], v1[3]);
                    *(u32x4e*)(rowp + bj * HALF) = w; } }
    }
};
struct EpiInProj {
    static constexpr bool PERM = true, AFTER_DRAIN = false;
    bf16_t *Z, *XBC, *UV; float* DT;
    __device__ __forceinline__ void operator()(const f32x4 (&acc)[2][2][4][2], const Unit& u, int wr, int wc, int fr, int fq) const {
        const int row0 = u.pm * BM + wr * 64 + fr;
        if (u.pn == 18) {
            if (wc == 0 && fq < 2) {
#pragma unroll
                for (int ai = 0; ai < 2; ++ai)
#pragma unroll
                    for (int m = 0; m < 4; ++m) { float* rp = DT + (size_t)(row0 + ai * HALF + m * 16) * 16 + 8 * fq;
                        *(f32x4*)(rp) = acc[ai][0][m][0]; *(f32x4*)(rp + 4) = acc[ai][0][m][1]; }
            }
            return;
        }
        bf16_t* base; int ldc, colt; bool act;
        if (u.pn < 4) { base = Z; ldc = 1024; colt = u.pn * BM; act = false; }
        else if (u.pn < 10) { base = XBC; ldc = 1536; colt = (u.pn - 4) * BM; act = false; }
        else { base = UV; ldc = 2048; colt = (u.pn - 10) * BM; act = true; }
        const int col0 = colt + wc * 32 + 8 * fq;
#pragma unroll
        for (int ai = 0; ai < 2; ++ai)
#pragma unroll
            for (int m = 0; m < 4; ++m) { bf16_t* rowp = base + (size_t)(row0 + ai * HALF + m * 16) * ldc + col0;
#pragma unroll
                for (int bj = 0; bj < 2; ++bj) { f32x4 v0 = acc[ai][bj][m][0], v1 = acc[ai][bj][m][1];
                    if (act) { f32x2 a = gelu_pk((f32x2){v0[0], v0[1]}), b = gelu_pk((f32x2){v0[2], v0[3]}), c = gelu_pk((f32x2){v1[0], v1[1]}), d = gelu_pk((f32x2){v1[2], v1[3]});
                        v0 = (f32x4){a.x, a.y, b.x, b.y}; v1 = (f32x4){c.x, c.y, d.x, d.y}; }
                    u32x4e w; w.x = cvt_pk_bf16(v0[0], v0[1]); w.y = cvt_pk_bf16(v0[2], v0[3]); w.z = cvt_pk_bf16(v1[0], v1[1]); w.w = cvt_pk_bf16(v1[2], v1[3]);
                    *(u32x4e*)(rowp + bj * HALF) = w; } }
    }
};
struct EpiRes {
    static constexpr bool PERM = false, AFTER_DRAIN = false;
    const float* base; float* out; float alpha;
    __device__ __forceinline__ void operator()(const f32x4 (&acc)[2][2][4][2], const Unit& u, int wr, int wc, int fr, int fq) const {
        const int row0 = u.pm * BM + wr * 64 + fr, col0 = u.pn * BM + wc * 32 + 4 * fq;
#pragma unroll
        for (int ai = 0; ai < 2; ++ai)
#pragma unroll
            for (int m = 0; m < 4; ++m) { const size_t off = (size_t)(row0 + ai * HALF + m * 16) * 1024 + col0;
#pragma unroll
                for (int bj = 0; bj < 2; ++bj)
#pragma unroll
                    for (int n = 0; n < 2; ++n) { const f32x4 bs = *(const f32x4*)(base + off + bj * HALF + n * 16);
                        *(f32x4*)(out + off + bj * HALF + n * 16) = bs * alpha + acc[ai][bj][m][n]; } }
    }
};
template <class Epi, class Sched, bool ALIGN_EPI = false, bool SP2 = false>
__device__ __forceinline__ void gemm_phase(PG8_LAS unsigned char* lds, const Gemm g, const Sched& S, const Epi& E) {
    const int tid = threadIdx.x, wid = __builtin_amdgcn_readfirstlane(tid >> 6), lane = tid & 63, wr = wid >> 2, wc = wid & 3, fr = lane & 15, fq = lane >> 4;
    const int K = g.K, nt = K / BK;
    unsigned voffA[2], voffB[2];
#pragma unroll
    for (int i = 0; i < 2; ++i) { int R, C; stage_rc(tid * 16 + i * 8192, R, C); const int Rb = Epi::PERM ? ((R & ~31) + perm32(R & 31)) : R;
        voffA[i] = (unsigned)(R * K + C) * 2u; voffB[i] = (unsigned)(Rb * K + C) * 2u; }
    const size_t kstep = (size_t)(BK * 2);
    const size_t hstep = (size_t)HALF * K * 2;
    const size_t tstep = 2 * hstep;
    const unsigned ldsw = (unsigned)wid * 1024u;
    const int aoff = lds_byte(wr * 64 + fr, fq * 8), boff = lds_byte(wc * 32 + fr, fq * 8);
#define PG8_SA(b, h) (((b) * 2 + (h)) * HTB)
#define PG8_SB(b, h) ((4 + (b) * 2 + (h)) * HTB)
#define PG8_STAGE(bufoff, gbase, voff) do { _Pragma("unroll") for (int _i = 0; _i < 2; ++_i) \
        __builtin_amdgcn_global_load_lds((const unsigned*)((const char*)(gbase) + (voff)[_i]), (PG8_LAS unsigned*)(lds + (bufoff) + ldsw + _i * 8192), 16, 0, 0); } while (0)
#define PG8_LDA(dst, b, h) do { _Pragma("unroll") for (int m = 0; m < 4; ++m) _Pragma("unroll") for (int k = 0; k < 2; ++k) dst[m][k] = *(const PG8_LAS bf16x8*)(lds + PG8_SA(b, h) + aoff + m * 2048 + k * 1024); } while (0)
#define PG8_LDB(dst, b, h) do { _Pragma("unroll") for (int n = 0; n < 2; ++n) _Pragma("unroll") for (int k = 0; k < 2; ++k) dst[n][k] = *(const PG8_LAS bf16x8*)(lds + PG8_SB(b, h) + boff + n * 2048 + k * 1024); } while (0)
#define PG8_MMA(ai, bj, At, Bt) do { __builtin_amdgcn_s_setprio(1); _Pragma("unroll") for (int m = 0; m < 4; ++m) _Pragma("unroll") for (int n = 0; n < 2; ++n) _Pragma("unroll") for (int k = 0; k < 2; ++k) \
        acc[ai][bj][m][n] = __builtin_amdgcn_mfma_f32_16x16x32_bf16(Bt[n][k], At[m][k], acc[ai][bj][m][n], 0, 0, 0); __builtin_amdgcn_s_setprio(0); } while (0)
#define PG8_WAIT_V(n) asm volatile("s_waitcnt vmcnt(" #n ")" ::: "memory")
#define PG8_WAIT_L(n) asm volatile("s_waitcnt lgkmcnt(" #n ")" ::: "memory")
#define PG8_BAR __builtin_amdgcn_s_barrier()
#define PG8_SCHED __builtin_amdgcn_sched_barrier(0)
    Unit cur, nxt; int ui = 0;
    if (!S.next(0, cur)) return;
    f32x4 acc[2][2][4][2];
#pragma unroll
    for (int a = 0; a < 2; ++a)
#pragma unroll
        for (int b = 0; b < 2; ++b)
#pragma unroll
            for (int m = 0; m < 4; ++m)
#pragma unroll
                for (int n = 0; n < 2; ++n) acc[a][b][m][n] = (f32x4){0.f, 0.f, 0.f, 0.f};
    bf16x8 At[4][2], B0[2][2], B1[2][2];
    const char* cA = (const char*)g.A + (size_t)cur.pm * tstep; const char* cB = (const char*)g.Bt + (size_t)cur.pn * tstep;
    S.a_ready(cur);
    if constexpr (SP2) {
        PG8_STAGE(PG8_SB(0, 0), cB, voffB); PG8_STAGE(PG8_SB(0, 1), cB + hstep, voffB); PG8_STAGE(PG8_SA(0, 0), cA, voffA); PG8_STAGE(PG8_SA(0, 1), cA + hstep, voffA);
        if (wr == 1) PG8_BAR;
        PG8_WAIT_V(2); PG8_BAR;
        PG8_STAGE(PG8_SB(1, 0), cB + kstep, voffB); PG8_STAGE(PG8_SA(1, 0), cA + kstep, voffA); PG8_STAGE(PG8_SB(1, 1), cB + hstep + kstep, voffB);
        PG8_WAIT_V(6); PG8_BAR;
    } else {
        PG8_STAGE(PG8_SB(0, 0), cB, voffB); PG8_STAGE(PG8_SA(0, 0), cA, voffA); PG8_STAGE(PG8_SB(0, 1), cB + hstep, voffB); PG8_STAGE(PG8_SA(0, 1), cA + hstep, voffA);
        if (wr == 1) PG8_BAR;
        PG8_WAIT_V(4); PG8_BAR;
        PG8_STAGE(PG8_SB(1, 0), cB + kstep, voffB); PG8_STAGE(PG8_SA(1, 0), cA + kstep, voffA); PG8_STAGE(PG8_SB(1, 1), cB + hstep + kstep, voffB);
        PG8_WAIT_V(6); PG8_BAR;
    }
    for (;;) {
        const bool has_next = S.next(ui + 1, nxt);
        const char* nA = has_next ? (const char*)g.A + (size_t)nxt.pm * tstep : cA; const char* nB = has_next ? (const char*)g.Bt + (size_t)nxt.pn * tstep : cB;
        for (int t = 0; t < nt; t += 2) {
            const bool last = (t == nt - 2);
            const char* a1 = cA + (size_t)(t + 1) * kstep;
            const char* a2 = last ? nA : cA + (size_t)(t + 2) * kstep; const char* b2 = last ? nB : cB + (size_t)(t + 2) * kstep;
            const char* a3 = a2 + kstep; const char* b3 = b2 + kstep;
            if (last && has_next) S.a_ready(nxt);
            if constexpr (SP2) {
            PG8_LDB(B0, 0, 0); PG8_LDB(B1, 0, 1); PG8_SCHED; PG8_LDA(At, 0, 0); PG8_STAGE(PG8_SA(1, 1), a1 + hstep, voffA);
            PG8_WAIT_V(8); PG8_WAIT_L(0); PG8_BAR; PG8_MMA(0, 0, At, B0); PG8_MMA(0, 1, At, B1); PG8_BAR; PG8_SCHED;
            PG8_LDA(At, 0, 1); PG8_STAGE(PG8_SB(0, 0), b2, voffB); PG8_STAGE(PG8_SB(0, 1), b2 + hstep, voffB); PG8_STAGE(PG8_SA(0, 0), a2, voffA);
            PG8_WAIT_V(8); PG8_WAIT_L(0); PG8_BAR; PG8_MMA(1, 0, At, B0); PG8_MMA(1, 1, At, B1); PG8_BAR; PG8_SCHED;
            PG8_LDB(B0, 1, 0); PG8_LDB(B1, 1, 1); PG8_SCHED; PG8_LDA(At, 1, 0); PG8_STAGE(PG8_SA(0, 1), a2 + hstep, voffA);
            PG8_WAIT_V(8); PG8_WAIT_L(0); PG8_BAR; PG8_MMA(0, 0, At, B0); PG8_MMA(0, 1, At, B1); PG8_BAR; PG8_SCHED;
            PG8_LDA(At, 1, 1); PG8_STAGE(PG8_SB(1, 0), b3, voffB); PG8_STAGE(PG8_SB(1, 1), b3 + hstep, voffB); PG8_STAGE(PG8_SA(1, 0), a3, voffA);
            PG8_WAIT_V(8); PG8_WAIT_L(0); PG8_BAR; PG8_MMA(1, 0, At, B0); PG8_MMA(1, 1, At, B1); PG8_BAR; PG8_SCHED;
            } else {
            PG8_LDB(B0, 0, 0); PG8_SCHED; PG8_LDA(At, 0, 0); PG8_STAGE(PG8_SA(1, 1), a1 + hstep, voffA);
            PG8_WAIT_L(8); PG8_BAR; PG8_WAIT_L(0); PG8_MMA(0, 0, At, B0); PG8_BAR; PG8_SCHED;
            PG8_LDB(B1, 0, 1); PG8_STAGE(PG8_SB(0, 0), b2, voffB);
            PG8_BAR; PG8_WAIT_L(0); PG8_MMA(0, 1, At, B1); PG8_BAR;
            PG8_LDA(At, 0, 1); PG8_STAGE(PG8_SA(0, 0), a2, voffA);
            PG8_BAR; PG8_WAIT_L(0); PG8_MMA(1, 0, At, B0); PG8_BAR; PG8_SCHED;
            PG8_STAGE(PG8_SB(0, 1), b2 + hstep, voffB);
            PG8_WAIT_V(6); PG8_BAR; PG8_MMA(1, 1, At, B1); PG8_BAR;
            PG8_LDB(B0, 1, 0); PG8_SCHED; PG8_LDA(At, 1, 0); PG8_STAGE(PG8_SA(0, 1), a2 + hstep, voffA);
            PG8_WAIT_L(8); PG8_BAR; PG8_WAIT_L(0); PG8_MMA(0, 0, At, B0); PG8_BAR; PG8_SCHED;
            PG8_LDB(B1, 1, 1); PG8_STAGE(PG8_SB(1, 0), b3, voffB);
            PG8_BAR; PG8_WAIT_L(0); PG8_MMA(0, 1, At, B1); PG8_BAR;
            PG8_LDA(At, 1, 1); PG8_STAGE(PG8_SA(1, 0), a3, voffA);
            PG8_BAR; PG8_WAIT_L(0); PG8_MMA(1, 0, At, B0); PG8_BAR; PG8_SCHED;
            PG8_STAGE(PG8_SB(1, 1), b3 + hstep, voffB);
            PG8_WAIT_V(6); PG8_BAR; PG8_MMA(1, 1, At, B1); PG8_BAR;
            }
        }
        if constexpr (ALIGN_EPI) { if (wr == 0) PG8_BAR; }
        if constexpr (!Epi::AFTER_DRAIN) { E(acc, cur, wr, wc, fr, fq); S.done(cur); }
        if (!has_next) break;
#pragma unroll
        for (int a = 0; a < 2; ++a)
#pragma unroll
            for (int b = 0; b < 2; ++b)
#pragma unroll
                for (int m = 0; m < 4; ++m)
#pragma unroll
                    for (int n = 0; n < 2; ++n) acc[a][b][m][n] = (f32x4){0.f, 0.f, 0.f, 0.f};
        cur = nxt; cA = nA; cB = nB; ++ui;
        if constexpr (ALIGN_EPI) { if (wr == 1) PG8_BAR; }
    }
    PG8_WAIT_V(0);
    if constexpr (!ALIGN_EPI) { if (wr == 0) PG8_BAR; }
    PG8_BAR;
    if constexpr (Epi::AFTER_DRAIN) { E.fused(acc, cur, wr, wc, fr, fq, lds, wid, lane); S.done(cur); }
#undef PG8_SA
#undef PG8_SB
#undef PG8_STAGE
#undef PG8_LDA
#undef PG8_LDB
#undef PG8_MMA
#undef PG8_WAIT_V
#undef PG8_WAIT_L
#undef PG8_BAR
#undef PG8_SCHED
}
}
#define XB_TMO      128
#define XB_XCNT(j)  (256  + 64 * (j))
#define XB_XSUB(j)  (1280 + 64 * (j))
#define XB_XGEN(j)  (2304 + 64 * (j))
#define XB_TOP      3328
#define XB_TOPGEN   3392
#define XCD_BAR_WORDS 3456
#define XB_SPIN_CAP (1u << 18)

__device__ __forceinline__ unsigned xb_ld(unsigned* p)              { return __hip_atomic_load(p, __ATOMIC_RELAXED, __HIP_MEMORY_SCOPE_AGENT); }
__device__ __forceinline__ unsigned xb_add(unsigned* p, unsigned v) { return __hip_atomic_fetch_add(p, v, __ATOMIC_RELAXED, __HIP_MEMORY_SCOPE_AGENT); }
__device__ __forceinline__ unsigned xb_xcc_id() { return (unsigned)__builtin_amdgcn_s_getreg((3 << 11) | 20) & 0xFu; }
#define XB_SPIN(cond, bar) do { unsigned _sp = 0; while (cond) { __builtin_amdgcn_s_sleep(1); \
    if ((++_sp & 255u) == 0u) { if (xb_ld(&(bar)[XB_TMO])) break; if (_sp > XB_SPIN_CAP) { atomicAdd(&(bar)[XB_TMO], 1u); break; } } } } while (0)

struct XcdBarrier {
    unsigned* bar; unsigned x;
    volatile LAS unsigned* st;
};

__device__ __forceinline__ XcdBarrier xcd_barrier_post(unsigned* bar, volatile LAS unsigned* st) {
    XcdBarrier b; b.bar = bar; b.x = xb_xcc_id(); b.st = st;
    if (threadIdx.x == 0) (void)xb_add(&bar[XB_XCNT(b.x)], 1u);
    return b;
}
__device__ __forceinline__ void xcd_barrier_complete(unsigned* bar, unsigned x, unsigned& nloc, unsigned& nx) {
    const unsigned G = gridDim.x * gridDim.y * gridDim.z;
    unsigned sum, cnt, mine, sp = 0u;
    for (;;) {
        sum = 0u; cnt = 0u; mine = 0u;
#pragma unroll
        for (unsigned j = 0; j < 16; ++j) { const unsigned c = xb_ld(&bar[XB_XCNT(j)]); sum += c; cnt += (c > 0u) ? 1u : 0u; mine = (j == x) ? c : mine; }
        if (sum == G) break;
        __builtin_amdgcn_s_sleep(1);
        if ((++sp & 255u) == 0u) { if (xb_ld(&bar[XB_TMO])) break; if (sp > XB_SPIN_CAP) { atomicAdd(&bar[XB_TMO], 1u); break; } }
    }
    nloc = mine > 0u ? mine : 1u; nx = cnt > 0u ? cnt : 1u;
}

__device__ __forceinline__ void xcd_barrier(const XcdBarrier& b) {
    asm volatile("s_waitcnt vmcnt(0)" ::: "memory");
    __syncthreads();
    if (threadIdx.x == 0) {
        unsigned* bar = b.bar;
        __builtin_amdgcn_s_waitcnt(0);
        unsigned nloc = b.st[0], nx = b.st[1];
        if (nloc == 0u) { xcd_barrier_complete(bar, b.x, nloc, nx); b.st[0] = nloc; b.st[1] = nx; }
        const unsigned old = xb_add(&bar[XB_XSUB(b.x)], 1u);
        const unsigned gen = old / nloc;
        if (old + 1u == (gen + 1u) * nloc) {
            __builtin_amdgcn_fence(__ATOMIC_RELEASE, "agent");
            asm volatile("s_waitcnt vmcnt(0)" ::: "memory");
            const unsigned og = xb_add(&bar[XB_TOP], 1u);
            const unsigned tg = og / nx;
            if (og + 1u == (tg + 1u) * nx) xb_add(&bar[XB_TOPGEN], 1u);
            else XB_SPIN(xb_ld(&bar[XB_TOPGEN]) == tg, bar);
            __builtin_amdgcn_fence(__ATOMIC_ACQUIRE, "agent");
            xb_add(&bar[XB_XGEN(b.x)], 1u);
            asm volatile("s_waitcnt vmcnt(0)" ::: "memory");
        } else {
            XB_SPIN(xb_ld(&bar[XB_XGEN(b.x)]) == gen, bar);
            __builtin_amdgcn_fence(__ATOMIC_ACQUIRE, "agent");
            asm volatile("s_waitcnt vmcnt(0)" ::: "memory");
        }
    }
    __syncthreads();
}

#define LAS __attribute__((address_space(3)))
typedef unsigned short bf16_t;
typedef short bf16x8 __attribute__((ext_vector_type(8)));
typedef float f32x4 __attribute__((ext_vector_type(4)));
typedef float f32x16 __attribute__((ext_vector_type(16)));
typedef unsigned u32x4 __attribute__((ext_vector_type(4)));
typedef unsigned u32x2 __attribute__((ext_vector_type(2)));
typedef float f32x2_t __attribute__((ext_vector_type(2)));
typedef __bf16 bf16x2_t __attribute__((ext_vector_type(2)));

constexpr int M = 32768, SEQ = 4096, DM = 1024, NB = 8;
constexpr int NWAVES = 8, NTHR = 512;
constexpr int LDS_BYTES = 147456;
constexpr float LN_EPS = 1e-5f;
constexpr float ALPHA = 1.4142135623730951f;
constexpr float LOG2E = 1.4426950408889634f;
constexpr float QSCALE = 0.125f * LOG2E;
constexpr float LAMBDA_INIT = 0.8f - 0.6f * 0.7408182206817179f;
constexpr int NPHASE = 17;
#ifndef REP_SYNC
#define REP_SYNC 1
#endif
#ifndef REP_P0
#define REP_P0 1
#endif
#ifndef REP_SSD
#define REP_SSD 1
#endif
#ifndef REP_ATTN
#define REP_ATTN 1
#endif
#ifndef REP_MIX
#define REP_MIX 1
#endif

constexpr size_t MiB = 1u << 20;
constexpr size_t WS_WIN = 1 * MiB, WS_WOUT0 = 11 * MiB, WS_WUP0 = 15 * MiB, WS_WDN0 = 23 * MiB, WS_WQK = 31 * MiB, WS_WV = 35 * MiB,
                 WS_WO1 = 37 * MiB, WS_WUP1 = 39 * MiB, WS_WDN1 = 47 * MiB, WS_SGUW = 55 * MiB;
constexpr size_t WS_XB = 64 * MiB;
constexpr size_t WS_BIG = 128 * MiB;
constexpr size_t WS_XBC = 384 * MiB;
constexpr size_t WS_DT = 480 * MiB;
constexpr size_t WS_END = 482 * MiB;

__device__ __forceinline__ unsigned pk2(float lo, float hi) { f32x2_t v = {lo, hi}; bf16x2_t b = __builtin_convertvector(v, bf16x2_t); return __builtin_bit_cast(unsigned, b); }
__device__ __forceinline__ float bflo(unsigned u) { return __uint_as_float(u << 16); }
__device__ __forceinline__ float bfhi(unsigned u) { return __uint_as_float(u & 0xffff0000u); }
__device__ __forceinline__ float bf2f(bf16_t h) { return __uint_as_float((unsigned)h << 16); }
__device__ __forceinline__ bf16_t f2bf(float f) { return (bf16_t)(pk2(f, 0.f) & 0xffffu); }
__device__ __forceinline__ float wave_sum(float v) {
#pragma unroll
    for (int o = 1; o < 64; o <<= 1) v += __shfl_xor(v, o);
    return v;
}
__device__ __forceinline__ float sigmoidf_(float x) { return 1.0f / (1.0f + __expf(-x)); }
#define MFMA16(a, b, c) __builtin_amdgcn_mfma_f32_16x16x32_bf16((a), (b), (c), 0, 0, 0)
#define MFMA32(a, b, c) __builtin_amdgcn_mfma_f32_32x32x16_bf16((a), (b), (c), 0, 0, 0)

__device__ __forceinline__ void tr_item(const float* W, int ld, int c0, bf16_t* WT, int K, int row0, float scale, LAS float* scr, int kb, int nb, int lane) {
    const int k0 = 64 * kb, n0 = 32 * nb;
#pragma unroll 8
    for (int i = 0; i < 32; ++i) { const int kk = 2 * i + (lane >> 5); scr[kk * 33 + (lane & 31)] = W[(size_t)(k0 + kk) * ld + c0 + n0 + (lane & 31)] * scale; }
    asm volatile("s_waitcnt lgkmcnt(0)" ::: "memory");
    const int c = lane & 7;
#pragma unroll
    for (int j = 0; j < 4; ++j) { const int n = (lane >> 3) + 8 * j; const LAS float* s = scr + (8 * c) * 33 + n;
        u32x4 o; o.x = pk2(s[0 * 33], s[1 * 33]); o.y = pk2(s[2 * 33], s[3 * 33]); o.z = pk2(s[4 * 33], s[5 * 33]); o.w = pk2(s[6 * 33], s[7 * 33]);
        *(u32x4*)(WT + (size_t)(row0 + n0 + n) * K + k0 + 8 * c) = o; }
    asm volatile("s_waitcnt lgkmcnt(0)" ::: "memory");
}
struct P0Args { const float *x, *w_in, *w_out0, *w_up, *w_dn, *w_qkv, *w_o1, *sgu_w; unsigned char* ws; };
__device__ __forceinline__ void p0_prologue(LAS unsigned char* lds, const P0Args& a, int G) {
    const int tid = threadIdx.x, lane = tid & 63, wid = __builtin_amdgcn_readfirstlane(tid >> 6);
    LAS float* scr = (LAS float*)(lds + wid * 16384);
    const int gw = blockIdx.x * NWAVES + wid, NGW = G * NWAVES;
    bf16_t* WIN = (bf16_t*)(a.ws + WS_WIN);
#define TR_MAT(src, ld, c0, ncols, dst, K, row0, scale) { const int nblk = (ncols) / 32, nit = ((K) / 64) * nblk; \
        if (r < nit) { tr_item((src), (ld), (c0), (dst), (K), (row0), (scale), scr, r / nblk, r % nblk, lane); continue; } r -= nit; }
    constexpr int NIT = 16 * 80 + 16 * 64 + 32 * 32 + 2 * (16 * 128) + 2 * (64 * 32) + 16 * 32 + 16 * 32 + 16 * 32 + 16 * 32;
    for (int it = gw; it < NIT; it += NGW) {
        int r = it;
        TR_MAT(a.w_in, 4624, 0, 2560, WIN, 1024, 0, 1.f)
        TR_MAT(a.w_in, 4624, 2576, 2048, WIN, 1024, 2560, 1.f)
        TR_MAT(a.w_out0, 1024, 0, 1024, (bf16_t*)(a.ws + WS_WOUT0), 2048, 0, 1.f)
        TR_MAT(a.w_up, 4096, 0, 4096, (bf16_t*)(a.ws + WS_WUP0), 1024, 0, 1.f)
        TR_MAT(a.w_up + (size_t)1024 * 4096, 4096, 0, 4096, (bf16_t*)(a.ws + WS_WUP1), 1024, 0, 1.f)
        TR_MAT(a.w_dn, 1024, 0, 1024, (bf16_t*)(a.ws + WS_WDN0), 4096, 0, 1.f)
        TR_MAT(a.w_dn + (size_t)4096 * 1024, 1024, 0, 1024, (bf16_t*)(a.ws + WS_WDN1), 4096, 0, 1.f)
        TR_MAT(a.w_qkv, 3072, 0, 1024, (bf16_t*)(a.ws + WS_WQK), 1024, 0, QSCALE)
        TR_MAT(a.w_qkv, 3072, 1024, 1024, (bf16_t*)(a.ws + WS_WQK), 1024, 1024, 1.f)
        TR_MAT(a.w_qkv, 3072, 2048, 1024, (bf16_t*)(a.ws + WS_WV), 1024, 0, 1.f)
        TR_MAT(a.w_o1, 1024, 0, 1024, (bf16_t*)(a.ws + WS_WO1), 1024, 0, 1.f)
    }
#undef TR_MAT
    const size_t gt = (size_t)blockIdx.x * NTHR + tid, NGT = (size_t)G * NTHR;
    for (size_t i = gt; i < (size_t)256 * 1024; i += NGT) { const int n = (int)(i >> 10), k = (int)(i & 1023);
        WIN[(size_t)(4608 + n) * 1024 + k] = n < 16 ? f2bf(a.w_in[(size_t)k * 4624 + 2560 + n]) : (bf16_t)0; }
    bf16_t* SW = (bf16_t*)(a.ws + WS_SGUW);
    for (size_t i = gt; i < (size_t)8 * 128 * 128; i += NGT) { const int s = (int)(i & 127), t = (int)((i >> 7) & 127);
        SW[i] = ((t >> 6) >= (s >> 6)) ? f2bf(a.sgu_w[i]) : (bf16_t)0; }
    bf16_t* XB = (bf16_t*)(a.ws + WS_XB);
    for (size_t i = gt; i < (size_t)M * DM / 8; i += NGT) { const f32x4 v0 = *(const f32x4*)(a.x + i * 8), v1 = *(const f32x4*)(a.x + i * 8 + 4);
        u32x4 o; o.x = pk2(v0[0], v0[1]); o.y = pk2(v0[2], v0[3]); o.z = pk2(v1[0], v1[1]); o.w = pk2(v1[2], v1[3]); *(u32x4*)(XB + i * 8) = o; }
}

__device__ __forceinline__ void ln_phase(float* buf, bf16_t* xb, const float* g, const float* b, int G) {
    const int tid = threadIdx.x, lane = tid & 63, wid = tid >> 6;
    const int gw = blockIdx.x * NWAVES + wid, NGW = G * NWAVES;
    f32x4 gv[4], bv[4];
#pragma unroll
    for (int j = 0; j < 4; ++j) { gv[j] = *(const f32x4*)(g + lane * 4 + 256 * j); bv[j] = *(const f32x4*)(b + lane * 4 + 256 * j); }
    for (int m = gw; m < M; m += NGW) {
        float* row = buf + (size_t)m * DM + lane * 4;
        f32x4 v[4]; float s = 0.f;
#pragma unroll
        for (int j = 0; j < 4; ++j) { v[j] = *(const f32x4*)(row + 256 * j); s += (v[j][0] + v[j][1]) + (v[j][2] + v[j][3]); }
        const float mean = wave_sum(s) * (1.f / DM); float s2 = 0.f;
#pragma unroll
        for (int j = 0; j < 4; ++j) { v[j] = v[j] - mean; s2 += (v[j][0] * v[j][0] + v[j][1] * v[j][1]) + (v[j][2] * v[j][2] + v[j][3] * v[j][3]); }
        const float rstd = 1.f / sqrtf(wave_sum(s2) * (1.f / DM) + LN_EPS);
        bf16_t* xr = xb + (size_t)m * DM + lane * 4;
#pragma unroll
        for (int j = 0; j < 4; ++j) { const f32x4 o = v[j] * rstd * gv[j] + bv[j]; *(f32x4*)(row + 256 * j) = o;
            u32x2 w; w.x = pk2(o[0], o[1]); w.y = pk2(o[2], o[3]); *(u32x2*)(xr + 256 * j) = w; }
    }
}

struct SsdArgs { const bf16_t* XBC; const float* DT; bf16_t* Y; const float *conv_w, *conv_b, *dt_bias, *a_log, *d_skip; };
__device__ __forceinline__ void ssd_load(u32x4 (&raw)[7], const bf16_t* XBC, int b, int c, int rr, int colg) {
#pragma unroll
    for (int i = 0; i < 7; ++i) { const int tr = c * 64 + 4 * rr - 3 + i;
        raw[i] = tr >= 0 ? *(const u32x4*)(XBC + (size_t)(b * SEQ + tr) * 1536 + colg) : (u32x4){0u, 0u, 0u, 0u}; }
}
__device__ __forceinline__ void ssd_conv_task(const u32x4 (&raw)[7], int cgi, int rr, const float (&wj)[4], LAS float* CW, LAS bf16_t* Bs, LAS bf16_t* Cs, LAS bf16_t* BsT,
                                              LAS bf16_t* xT, LAS bf16_t* xwT, LAS float* xs) {
    u32x4 pack[4];
#pragma unroll
    for (int ep = 0; ep < 4; ++ep) {
        float i0[7], i1[7];
#pragma unroll
        for (int i = 0; i < 7; ++i) { const unsigned u = raw[i][ep]; i0[i] = bflo(u); i1[i] = bfhi(u); }
        const int lc = cgi * 8 + 2 * ep;
        float w0[5], w1[5];
#pragma unroll
        for (int k = 0; k < 5; ++k) { w0[k] = CW[k * 288 + lc]; w1[k] = CW[k * 288 + lc + 1]; }
        float o0[4], o1[4];
#pragma unroll
        for (int j = 0; j < 4; ++j) { float a = w0[4], c = w1[4];
#pragma unroll
            for (int k = 0; k < 4; ++k) { a += w0[k] * i0[j + k]; c += w1[k] * i1[j + k]; }
            o0[j] = a * sigmoidf_(a); o1[j] = c * sigmoidf_(c); }
#pragma unroll
        for (int j = 0; j < 4; ++j) pack[j][ep] = pk2(o0[j], o1[j]);
        if (cgi < 4) {
            const int p = cgi * 8 + 2 * ep;
#pragma unroll
            for (int j = 0; j < 4; ++j) { xs[(4 * rr + j) * 33 + p] = o0[j]; xs[(4 * rr + j) * 33 + p + 1] = o1[j]; }
            *(LAS u32x2*)(xT + p * 72 + 4 * rr) = (u32x2){pk2(o0[0], o0[1]), pk2(o0[2], o0[3])};
            *(LAS u32x2*)(xT + (p + 1) * 72 + 4 * rr) = (u32x2){pk2(o1[0], o1[1]), pk2(o1[2], o1[3])};
            *(LAS u32x2*)(xwT + p * 72 + 4 * rr) = (u32x2){pk2(o0[0] * wj[0], o0[1] * wj[1]), pk2(o0[2] * wj[2], o0[3] * wj[3])};
            *(LAS u32x2*)(xwT + (p + 1) * 72 + 4 * rr) = (u32x2){pk2(o1[0] * wj[0], o1[1] * wj[1]), pk2(o1[2] * wj[2], o1[3] * wj[3])};
        } else if (cgi < 20) {
            const int n = (cgi - 4) * 8 + 2 * ep;
            *(LAS u32x2*)(BsT + n * 72 + 4 * rr) = (u32x2){pk2(o0[0], o0[1]), pk2(o0[2], o0[3])};
            *(LAS u32x2*)(BsT + (n + 1) * 72 + 4 * rr) = (u32x2){pk2(o1[0], o1[1]), pk2(o1[2], o1[3])};
        }
    }
    if (cgi >= 4 && cgi < 20) {
#pragma unroll
        for (int j = 0; j < 4; ++j) *(LAS u32x4*)(Bs + (4 * rr + j) * 136 + (cgi - 4) * 8) = pack[j];
    } else if (cgi >= 20) {
#pragma unroll
        for (int j = 0; j < 4; ++j) *(LAS u32x4*)(Cs + (4 * rr + j) * 136 + (cgi - 20) * 8) = pack[j];
    }
}
__device__ __forceinline__ void ssd_phase(LAS unsigned char* lds, const SsdArgs& A, int G) {
    const int tid = threadIdx.x, lane = tid & 63, wid = __builtin_amdgcn_readfirstlane(tid >> 6), l15 = lane & 15, quad = lane >> 4;
    LAS float* CW = (LAS float*)(lds);
    LAS float* DTS = (LAS float*)(lds + 6144);
    LAS bf16_t* Bs = (LAS bf16_t*)(lds + 8192);
    LAS bf16_t* Cs = Bs + 64 * 136;
    LAS bf16_t* BsT = Cs + 64 * 136;
    LAS bf16_t* xT = BsT + 128 * 72;
    LAS bf16_t* xwT = xT + 32 * 72;
    LAS bf16_t* Lm = xwT + 32 * 72;
    LAS bf16_t* St = Lm + 64 * 72;
    LAS float* xs = (LAS float*)(St + 32 * 136);
    for (int item = blockIdx.x; item < 256; item += G) {
        const int b = item >> 5, h = (item >> 1) & 15, ph = item & 1, g = h >> 3;
        __syncthreads();
        for (int idx = tid; idx < 5 * 288; idx += NTHR) { const int k = idx / 288, lc = idx % 288;
            const int col = lc < 32 ? h * 64 + ph * 32 + lc : (lc < 160 ? 1024 + g * 128 + (lc - 32) : 1280 + g * 128 + (lc - 160));
            CW[idx] = k < 4 ? A.conv_w[k * 1536 + col] : A.conv_b[col]; }
        for (int idx = tid; idx < 32 * 136 / 2; idx += NTHR) ((LAS unsigned*)St)[idx] = 0u;
        const float a_h = -__expf(A.a_log[h]), dtb = A.dt_bias[h], Dh = A.d_skip[h];
        const int cg0 = tid % 36, rr0 = tid / 36, cg1 = (tid + 512) % 36, rr1 = (tid + 512) / 36;
        const int colg0 = cg0 < 4 ? h * 64 + ph * 32 + cg0 * 8 : (cg0 < 20 ? 1024 + g * 128 + (cg0 - 4) * 8 : 1280 + g * 128 + (cg0 - 20) * 8);
        const int colg1 = cg1 < 4 ? h * 64 + ph * 32 + cg1 * 8 : (cg1 < 20 ? 1024 + g * 128 + (cg1 - 4) * 8 : 1280 + g * 128 + (cg1 - 20) * 8);
        u32x4 raw0[7], raw1[7]; float dtraw;
        ssd_load(raw0, A.XBC, b, 0, rr0, colg0);
        if (tid < 64) ssd_load(raw1, A.XBC, b, 0, rr1, colg1);
        dtraw = A.DT[(size_t)(b * SEQ + lane) * 16 + h];
        f32x4 state[2]; state[0] = (f32x4){0.f, 0.f, 0.f, 0.f}; state[1] = (f32x4){0.f, 0.f, 0.f, 0.f};
        __syncthreads();
        for (int c = 0; c < 64; ++c) {
            const int rowbase = b * SEQ + c * 64;
            const float xdt = dtraw + dtb; const float dtv = xdt > 20.f ? xdt : log1pf(__expf(xdt));
            float acs = dtv * a_h;
#pragma unroll
            for (int off = 1; off < 64; off <<= 1) { const float t = __shfl_up(acs, off); if (lane >= off) acs += t; }
            const float acs63 = __shfl(acs, 63);
            const float wl = dtv * __expf(acs63 - acs);
            if (wid == 0) { DTS[lane] = dtv; DTS[64 + lane] = acs; DTS[128 + lane] = __expf(acs); }
            float wj0[4], wj1[4];
#pragma unroll
            for (int j = 0; j < 4; ++j) { wj0[j] = __shfl(wl, (4 * rr0 + j) & 63); wj1[j] = __shfl(wl, (4 * rr1 + j) & 63); }
            ssd_conv_task(raw0, cg0, rr0, wj0, CW, Bs, Cs, BsT, xT, xwT, xs);
            if (tid < 64) ssd_conv_task(raw1, cg1, rr1, wj1, CW, Bs, Cs, BsT, xT, xwT, xs);
            __syncthreads();
            if (c < 63) { ssd_load(raw0, A.XBC, b, c + 1, rr0, colg0); if (tid < 64) ssd_load(raw1, A.XBC, b, c + 1, rr1, colg1);
                dtraw = A.DT[(size_t)(rowbase + 64 + lane) * 16 + h]; }
            { const int ti = wid & 3, sjb = (wid >> 2) * 2;
#pragma unroll
              for (int q = 0; q < 2; ++q) { const int sj = sjb + q; f32x4 acc = (f32x4){0.f, 0.f, 0.f, 0.f};
                if (sj <= ti) {
#pragma unroll
                    for (int kk = 0; kk < 4; ++kk) { const bf16x8 av = *(const LAS bf16x8*)(Cs + (16 * ti + l15) * 136 + kk * 32 + quad * 8);
                        const bf16x8 bv = *(const LAS bf16x8*)(Bs + (16 * sj + l15) * 136 + kk * 32 + quad * 8); acc = MFMA16(av, bv, acc); }
                }
                const int s = 16 * sj + l15; const float acs_s = DTS[64 + s], dt_s = DTS[s];
#pragma unroll
                for (int r = 0; r < 4; ++r) { const int t = 16 * ti + 4 * quad + r; const float acs_t = DTS[64 + t];
                    const float v = (s <= t) ? acc[r] * __expf(acs_t - acs_s) * dt_s : 0.f; Lm[t * 72 + s] = f2bf(v); } } }
            __syncthreads();
            { const int ti = wid & 3, pj = wid >> 2; f32x4 accd = (f32x4){0.f, 0.f, 0.f, 0.f}, acco = (f32x4){0.f, 0.f, 0.f, 0.f};
#pragma unroll
              for (int kk = 0; kk < 2; ++kk) { const bf16x8 av = *(const LAS bf16x8*)(Lm + (16 * ti + l15) * 72 + kk * 32 + quad * 8);
                  const bf16x8 bv = *(const LAS bf16x8*)(xT + (16 * pj + l15) * 72 + kk * 32 + quad * 8); accd = MFMA16(av, bv, accd); }
#pragma unroll
              for (int kk = 0; kk < 4; ++kk) { const bf16x8 av = *(const LAS bf16x8*)(Cs + (16 * ti + l15) * 136 + kk * 32 + quad * 8);
                  const bf16x8 bv = *(const LAS bf16x8*)(St + (16 * pj + l15) * 136 + kk * 32 + quad * 8); acco = MFMA16(av, bv, acco); }
              const int p = 16 * pj + l15;
#pragma unroll
              for (int r = 0; r < 4; ++r) { const int t = 16 * ti + 4 * quad + r; const float y = accd[r] + DTS[128 + t] * acco[r] + Dh * xs[t * 33 + p];
                  A.Y[(size_t)(rowbase + t) * 1024 + h * 64 + ph * 32 + p] = f2bf(y); } }
            const int pi = wid & 1, njb = (wid >> 1) * 2; const float dec = __expf(acs63);
#pragma unroll
            for (int q = 0; q < 2; ++q) { const int nj = njb + q; f32x4 acc = (f32x4){0.f, 0.f, 0.f, 0.f};
#pragma unroll
                for (int kk = 0; kk < 2; ++kk) { const bf16x8 av = *(const LAS bf16x8*)(xwT + (16 * pi + l15) * 72 + kk * 32 + quad * 8);
                    const bf16x8 bv = *(const LAS bf16x8*)(BsT + (16 * nj + l15) * 72 + kk * 32 + quad * 8); acc = MFMA16(av, bv, acc); }
                state[q] = state[q] * dec + acc; }
            __syncthreads();
#pragma unroll
            for (int q = 0; q < 2; ++q)
#pragma unroll
                for (int r = 0; r < 4; ++r) St[(16 * pi + 4 * quad + r) * 136 + 16 * (njb + q) + l15] = f2bf(state[q][r]);
        }
    }
}

struct MixArgs { const bf16_t *Y, *Z, *UV, *SW; bf16_t* MIX; const float *norm_w, *ln_g, *ln_b, *sgu_b; };
__device__ __forceinline__ void mix_phase(LAS unsigned char* lds, const MixArgs& A, int G) {
    const int tid = threadIdx.x, lane = tid & 63, wid = __builtin_amdgcn_readfirstlane(tid >> 6), l15 = lane & 15, quad = lane >> 4;
    LAS float* stats = (LAS float*)lds;
    LAS bf16_t* VnT0 = (LAS bf16_t*)(lds + 1024);
    for (int u = blockIdx.x; u < M / 128; u += G) {
        const int m0 = u * 128;
        __syncthreads();
        for (int rr = wid; rr < 128; rr += NWAVES) {
            const size_t m = (size_t)(m0 + rr);
#pragma unroll
            for (int gi = 0; gi < 2; ++gi) {
                const int col = gi * 512 + lane * 8;
                const u32x4 yv = *(const u32x4*)(A.Y + m * 1024 + col), zv = *(const u32x4*)(A.Z + m * 1024 + col);
                float v[8]; float ss = 0.f;
#pragma unroll
                for (int e = 0; e < 4; ++e) { const float z0 = bflo(zv[e]), z1 = bfhi(zv[e]); v[2 * e] = bflo(yv[e]) * z0 * sigmoidf_(z0); v[2 * e + 1] = bfhi(yv[e]) * z1 * sigmoidf_(z1);
                    ss += v[2 * e] * v[2 * e] + v[2 * e + 1] * v[2 * e + 1]; }
                const float rs = 1.f / sqrtf(wave_sum(ss) * (1.f / 512.f) + LN_EPS);
                const f32x4 w0 = *(const f32x4*)(A.norm_w + col), w1 = *(const f32x4*)(A.norm_w + col + 4);
                u32x4 o; o.x = pk2(v[0] * rs * w0[0], v[1] * rs * w0[1]); o.y = pk2(v[2] * rs * w0[2], v[3] * rs * w0[3]);
                o.z = pk2(v[4] * rs * w1[0], v[5] * rs * w1[1]); o.w = pk2(v[6] * rs * w1[2], v[7] * rs * w1[3]);
                *(u32x4*)(A.MIX + m * 2048 + col) = o;
            }
            { const bf16_t* vr = A.UV + m * 2048 + 1024;
              const u32x4 a0 = *(const u32x4*)(vr + lane * 8), a1 = *(const u32x4*)(vr + 512 + lane * 8);
              float v[16]; float s = 0.f;
#pragma unroll
              for (int e = 0; e < 4; ++e) { v[2 * e] = bflo(a0[e]); v[2 * e + 1] = bfhi(a0[e]); v[8 + 2 * e] = bflo(a1[e]); v[8 + 2 * e + 1] = bfhi(a1[e]); }
#pragma unroll
              for (int e = 0; e < 16; ++e) s += v[e];
              const float mean = wave_sum(s) * (1.f / 1024.f); float s2 = 0.f;
#pragma unroll
              for (int e = 0; e < 16; ++e) { const float d = v[e] - mean; s2 += d * d; }
              const float rstd = 1.f / sqrtf(wave_sum(s2) * (1.f / 1024.f) + LN_EPS);
              if (lane == 0) { stats[2 * rr] = mean; stats[2 * rr + 1] = rstd; } }
        }
        __syncthreads();
        for (int gi = 0; gi < 8; ++gi) {
            LAS bf16_t* buf = VnT0 + (gi & 1) * (128 * 136);
#pragma unroll
            for (int i = 0; i < 4; ++i) { const int task = tid + NTHR * i, s = task & 127, cgp = task >> 7;
                const u32x4 vv = *(const u32x4*)(A.UV + (size_t)(m0 + s) * 2048 + 1024 + gi * 128 + cgp * 8);
                const float mean = stats[2 * s], rstd = stats[2 * s + 1];
                const f32x4 g0 = *(const f32x4*)(A.ln_g + gi * 128 + cgp * 8), g1 = *(const f32x4*)(A.ln_g + gi * 128 + cgp * 8 + 4);
                const f32x4 b0 = *(const f32x4*)(A.ln_b + gi * 128 + cgp * 8), b1 = *(const f32x4*)(A.ln_b + gi * 128 + cgp * 8 + 4);
#pragma unroll
                for (int e = 0; e < 4; ++e) { const float gA = e < 2 ? g0[2 * e] : g1[2 * e - 4], gB = e < 2 ? g0[2 * e + 1] : g1[2 * e - 3];
                    const float bA = e < 2 ? b0[2 * e] : b1[2 * e - 4], bB = e < 2 ? b0[2 * e + 1] : b1[2 * e - 3];
                    buf[(cgp * 8 + 2 * e) * 136 + s] = f2bf((bflo(vv[e]) - mean) * rstd * gA + bA);
                    buf[(cgp * 8 + 2 * e + 1) * 136 + s] = f2bf((bfhi(vv[e]) - mean) * rstd * gB + bB); } }
            __syncthreads();
            bf16x8 af[4];
#pragma unroll
            for (int kk = 0; kk < 4; ++kk) af[kk] = *(const bf16x8*)(A.SW + (size_t)gi * 16384 + (16 * wid + l15) * 128 + kk * 32 + quad * 8);
            float bias[4];
#pragma unroll
            for (int r = 0; r < 4; ++r) bias[r] = A.sgu_b[gi * 128 + 16 * wid + 4 * quad + r];
#pragma unroll 2
            for (int cj = 0; cj < 8; ++cj) { f32x4 acc = (f32x4){0.f, 0.f, 0.f, 0.f};
#pragma unroll
                for (int kk = 0; kk < 4; ++kk) { const bf16x8 bv = *(const LAS bf16x8*)(buf + (16 * cj + l15) * 136 + kk * 32 + quad * 8); acc = MFMA16(af[kk], bv, acc); }
#pragma unroll
                for (int r = 0; r < 4; ++r) { const size_t m = (size_t)(m0 + 16 * wid + 4 * quad + r); const int c = gi * 128 + 16 * cj + l15;
                    const float uval = bf2f(A.UV[m * 2048 + c]); A.MIX[m * 2048 + 1024 + c] = f2bf(uval * (acc[r] + bias[r])); } }
        }
    }
}

struct AttnArgs { const bf16_t *QK, *VT; bf16_t* AO; const float *lq1, *lk1, *lq2, *lk2, *subw; };
__device__ __forceinline__ int crow(int i, int hh) { return (i & 3) + 8 * (i >> 2) + 4 * hh; }
__device__ __forceinline__ void attn_phase(LAS unsigned char* lds, const AttnArgs& A, int G) {
    const int tid = threadIdx.x, lane = tid & 63, wid = __builtin_amdgcn_readfirstlane(tid >> 6), r = lane & 31, hh = lane >> 5;
    const int map = wid & 1, rg = wid >> 1;
    const float lam = __expf(wave_sum(A.lq1[lane] * A.lk1[lane])) - __expf(wave_sum(A.lq2[lane] * A.lk2[lane])) + LAMBDA_INIT;
    LAS bf16_t* Kbuf = (LAS bf16_t*)lds;
    LAS bf16_t* Vbuf = (LAS bf16_t*)(lds + 34816);
    LAS float* wsf = (LAS float*)(lds + 71680) + wid * 64;
    LAS float* XCH = (LAS float*)lds + rg * 4096;
    for (int vb = blockIdx.x; vb < 256; vb += G) {
        const int bh = vb >> 2, b = bh >> 3, h = bh & 7, sx = vb & 3;
        const float slope2 = exp2f(-(float)(h + 1)) * LOG2E;
        const int rowb = b * SEQ;
        for (int ui = 0; ui < 8; ++ui) {
            const int qb = (ui & 1) ? 8 * (ui >> 1) + 7 - sx : 8 * (ui >> 1) + sx;
            const int q0 = qb * 128, qc = 2 * qb + (rg >> 1), T0 = 2 * qb + 1;
            bf16x8 qf[4];
#pragma unroll
            for (int s = 0; s < 4; ++s) qf[s] = *(const bf16x8*)(A.QK + (size_t)(rowb + q0 + 32 * rg + r) * 2048 + h * 128 + map * 64 + 16 * s + 8 * hh);
            f32x16 O[4];
#pragma unroll
            for (int db = 0; db < 4; ++db)
#pragma unroll
                for (int i = 0; i < 16; ++i) O[db][i] = 0.f;
            float m_run = 0.f, l_run = 0.f;
            const int krow0 = tid >> 4, kcp = tid & 15, vd0 = tid >> 3, vcp = tid & 7;
            const bf16_t* ksrc = A.QK + (size_t)(rowb + krow0) * 2048 + 1024 + h * 128 + kcp * 8;
            const bf16_t* vsrc = A.VT + (size_t)(h * 128 + vd0) * M + rowb + vcp * 8;
            u32x4 kr0, kr1, vr0, vr1;
#define ATT_LOAD(kt) do { kr0 = *(const u32x4*)(ksrc + (size_t)((kt) * 64) * 2048); kr1 = *(const u32x4*)(ksrc + (size_t)((kt) * 64 + 32) * 2048); \
                          vr0 = *(const u32x4*)(vsrc + (kt) * 64); vr1 = *(const u32x4*)(vsrc + (size_t)64 * M + (kt) * 64); } while (0)
#define ATT_WRITE(bufi) do { *(LAS u32x4*)(Kbuf + (bufi) * (64 * 136) + krow0 * 136 + kcp * 8) = kr0; *(LAS u32x4*)(Kbuf + (bufi) * (64 * 136) + (krow0 + 32) * 136 + kcp * 8) = kr1; \
                             *(LAS u32x4*)(Vbuf + (bufi) * (128 * 72) + vd0 * 72 + vcp * 8) = vr0; *(LAS u32x4*)(Vbuf + (bufi) * (128 * 72) + (vd0 + 64) * 72 + vcp * 8) = vr1; } while (0)
            __syncthreads();
            ATT_LOAD(T0); ATT_WRITE(0);
            __syncthreads();
            int cur = 0;
            for (int kt = T0; kt >= 0; --kt) {
                if (kt > 0) ATT_LOAD(kt - 1);
                if (kt <= qc) {
                    const LAS bf16_t* Kb = Kbuf + cur * (64 * 136); const LAS bf16_t* Vb = Vbuf + cur * (128 * 72);
                    f32x16 sv[2];
                    {
                        float s2v = slope2; asm volatile("" : "+v"(s2v));
                        const float dlane = (float)(q0 + 32 * rg + r - kt * 64 - 4 * hh);
                        const float a_lane = -slope2 * dlane - m_run;
#pragma unroll
                        for (int kb = 0; kb < 2; ++kb) {
#pragma unroll
                            for (int i = 0; i < 16; ++i) sv[kb][i] = __builtin_fmaf(s2v, (float)(32 * kb + (i & 3) + 8 * (i >> 2)), a_lane);
#pragma unroll
                            for (int s = 0; s < 4; ++s) { const bf16x8 av = *(const LAS bf16x8*)(Kb + (32 * kb + r) * 136 + map * 64 + 16 * s + 8 * hh); sv[kb] = MFMA32(av, qf[s], sv[kb]); }
                        }
                        const bool diag = (kt == qc);
                        if (diag) {
                            const float s22 = 2.f * slope2;
#pragma unroll
                            for (int kb = 0; kb < 2; ++kb)
#pragma unroll
                                for (int i = 0; i < 16; ++i) sv[kb][i] = __builtin_fmaf(s22, fminf(dlane - (float)(32 * kb + (i & 3) + 8 * (i >> 2)), 0.f), sv[kb][i]);
                        }
                        float mx = -1e30f;
#pragma unroll
                        for (int kb = 0; kb < 2; ++kb)
#pragma unroll
                            for (int i = 0; i < 16; ++i) mx = fmaxf(mx, sv[kb][i]);
                        mx = fmaxf(mx, __shfl_xor(mx, 32));
                        if (diag || __any(mx > 6.0f)) {
                            const float dl = diag ? mx : fmaxf(mx, 0.f); m_run += dl;
                            const float alpha = __builtin_amdgcn_exp2f(-dl); l_run *= alpha;
                            if (hh == 0) wsf[r] = alpha;
#pragma unroll
                            for (int kb = 0; kb < 2; ++kb)
#pragma unroll
                                for (int i = 0; i < 16; ++i) sv[kb][i] -= dl;
                            if (!diag) {
#pragma unroll
                                for (int i = 0; i < 16; ++i) { const float al = wsf[crow(i, hh)];
#pragma unroll
                                    for (int db = 0; db < 4; ++db) O[db][i] *= al; }
                            }
                        }
                    }
                    float ps = 0.f;
#pragma unroll
                    for (int kb = 0; kb < 2; ++kb)
#pragma unroll
                        for (int i = 0; i < 16; ++i) { const float p = __builtin_amdgcn_exp2f(sv[kb][i]); sv[kb][i] = p; ps += p; }
                    l_run += ps;
#pragma unroll
                    for (int s2 = 0; s2 < 4; ++s2) { const int kb = s2 >> 1, hf = s2 & 1;
                        u32x4 pw; pw.x = pk2(sv[kb][8 * hf + 0], sv[kb][8 * hf + 1]); pw.y = pk2(sv[kb][8 * hf + 2], sv[kb][8 * hf + 3]);
                        pw.z = pk2(sv[kb][8 * hf + 4], sv[kb][8 * hf + 5]); pw.w = pk2(sv[kb][8 * hf + 6], sv[kb][8 * hf + 7]);
                        const bf16x8 pa = __builtin_bit_cast(bf16x8, pw);
#pragma unroll
                        for (int db = 0; db < 4; ++db) { const LAS bf16_t* vp = Vb + (32 * db + r) * 72 + 32 * kb + 16 * hf + 4 * hh;
                            const u32x2 lo = *(const LAS u32x2*)(vp), hi = *(const LAS u32x2*)(vp + 8);
                            u32x4 vw; vw.x = lo.x; vw.y = lo.y; vw.z = hi.x; vw.w = hi.y;
                            O[db] = MFMA32(pa, __builtin_bit_cast(bf16x8, vw), O[db]); } }
                }
                if (kt > 0) ATT_WRITE(cur ^ 1);
                __syncthreads();
                cur ^= 1;
            }
#undef ATT_LOAD
#undef ATT_WRITE
            const float l_tot = l_run + __shfl_xor(l_run, 32);
            if (hh == 0) wsf[32 + r] = 1.f / l_tot;
#pragma unroll
            for (int i = 0; i < 16; ++i) { const float li = wsf[32 + crow(i, hh)];
#pragma unroll
                for (int db = 0; db < 4; ++db) O[db][i] *= li; }
            if (map == 1) {
#pragma unroll
                for (int db = 0; db < 4; ++db)
#pragma unroll
                    for (int i = 0; i < 16; ++i) XCH[(db * 16 + i) * 64 + lane] = O[db][i];
            }
            __syncthreads();
            if (map == 0) {
                float ss[16];
#pragma unroll
                for (int i = 0; i < 16; ++i) { float a = 0.f;
#pragma unroll
                    for (int db = 0; db < 4; ++db) { const float o = O[db][i] - lam * XCH[(db * 16 + i) * 64 + lane]; O[db][i] = o; a += o * o; }
                    ss[i] = a; }
#pragma unroll
                for (int i = 0; i < 16; ++i) {
#pragma unroll
                    for (int o = 1; o < 32; o <<= 1) ss[i] += __shfl_xor(ss[i], o);
                    ss[i] = (1.f - LAMBDA_INIT) / sqrtf(ss[i] * (1.f / 128.f) + LN_EPS); }
#pragma unroll
                for (int db = 0; db < 4; ++db) { const float w = A.subw[32 * db + r];
#pragma unroll
                    for (int i = 0; i < 16; ++i) A.AO[(size_t)(rowb + q0 + 32 * rg + crow(i, hh)) * 1024 + h * 128 + 32 * db + r] = f2bf(O[db][i] * ss[i] * w); }
            }
        }
    }
}

struct Args { const float* in[26]; float* out; unsigned char* ws; int ph_lo, ph_hi; };
__global__ void __launch_bounds__(NTHR, 2) mega_fwd(Args args) {
    extern __shared__ __attribute__((aligned(16))) unsigned char lds_raw[];
    LAS unsigned char* lds = (LAS unsigned char*)lds_raw;
    cg::grid_group grid = cg::this_grid();
    const int G = gridDim.x;
    unsigned char* ws = args.ws;
    float* out = args.out;
    bf16_t* XB = (bf16_t*)(ws + WS_XB);
    bf16_t* MIX = (bf16_t*)(ws + WS_BIG);
    bf16_t* UV = (bf16_t*)(ws + WS_BIG + 128 * MiB);
    bf16_t* FF = (bf16_t*)(ws + WS_BIG);
    bf16_t* QK = (bf16_t*)(ws + WS_BIG);
    bf16_t* VT = (bf16_t*)(ws + WS_BIG + 128 * MiB);
    bf16_t* AO = (bf16_t*)(ws + WS_BIG + 192 * MiB);
    bf16_t* XBC = (bf16_t*)(ws + WS_XBC);
    float* DT = (float*)(ws + WS_DT);
    bf16_t* Zb = (bf16_t*)out;
    bf16_t* Yb = (bf16_t*)out + (size_t)M * 1024;
    const int lo = args.ph_lo, hi = args.ph_hi;
    if (threadIdx.x < 4) ((LAS unsigned*)(lds + LDS_BYTES - 16))[threadIdx.x] = 0u;
    __syncthreads();
    const XcdBarrier xbar = xcd_barrier_post((unsigned*)ws, (volatile LAS unsigned*)(lds + LDS_BYTES - 16));
#ifndef ONLY
#define EN(k) 1
#else
#define EN(k) ((ONLY)==(k))
#endif
#define IN(k) (EN(k) && lo <= (k) && (k) < hi)
#define SEAM(k) do { if ((k) + 1 < hi) { for (int rs_ = 0; rs_ < REP_SYNC; ++rs_) { if ((k) == 0) grid.sync(); else xcd_barrier(xbar); } } } while (0)
#define GEMM_RES(k, Aop, Wt, Kdim, rbase) if (IN(k)) { pg8::Gemm g{(Aop), (const bf16_t*)(ws + (Wt)), M, 1024, (Kdim)}; pg8::StaticOrder S; S.init(M, 1024, G, (int)blockIdx.x); \
        pg8::EpiRes E{(rbase), out, ALPHA}; pg8::gemm_phase<pg8::EpiRes, pg8::StaticOrder, true, true>(lds, g, S, E); SEAM(k); }
#define GEMM_UP(k, Wt) if (IN(k)) { pg8::Gemm g{XB, (const bf16_t*)(ws + (Wt)), M, 4096, 1024}; pg8::StaticOrder S; S.init(M, 4096, G, (int)blockIdx.x); \
        pg8::EpiPlain<2> E{FF, 4096}; pg8::gemm_phase<pg8::EpiPlain<2>, pg8::StaticOrder, true, true>(lds, g, S, E); SEAM(k); }
#define LNPH(k, gi, bi, l) if (IN(k)) { ln_phase(out, XB, args.in[gi] + (l) * 1024, args.in[bi] + (l) * 1024, G); SEAM(k); }
    if (IN(0)) { P0Args a{args.in[0], args.in[1], args.in[12], args.in[24], args.in[25], args.in[13], args.in[19], args.in[10], ws}; for (int rep = 0; rep < REP_P0; ++rep) p0_prologue(lds, a, G); SEAM(0); }
    if (IN(1)) { pg8::Gemm g{XB, (const bf16_t*)(ws + WS_WIN), M, 4864, 1024}; pg8::StaticOrder S; S.init(M, 4864, G, (int)blockIdx.x);
                 pg8::EpiInProj E{Zb, XBC, UV, DT}; pg8::gemm_phase<pg8::EpiInProj, pg8::StaticOrder, true, true>(lds, g, S, E); SEAM(1); }
    if (IN(2)) { SsdArgs a{XBC, DT, Yb, args.in[2], args.in[3], args.in[4], args.in[5], args.in[6]}; for (int rep = 0; rep < REP_SSD; ++rep) ssd_phase(lds, a, G); SEAM(2); }
    if (IN(3)) { MixArgs a{Yb, Zb, UV, (const bf16_t*)(ws + WS_SGUW), MIX, args.in[7], args.in[8], args.in[9], args.in[11]}; for (int rep = 0; rep < REP_MIX; ++rep) mix_phase(lds, a, G); SEAM(3); }
    GEMM_RES(4, MIX, WS_WOUT0, 2048, args.in[0])
    LNPH(5, 20, 21, 0)
    GEMM_UP(6, WS_WUP0)
    GEMM_RES(7, FF, WS_WDN0, 4096, out)
    LNPH(8, 22, 23, 0)
    if (IN(9)) { pg8::Gemm g{XB, (const bf16_t*)(ws + WS_WQK), M, 2048, 1024}; pg8::StaticOrder S; S.init(M, 2048, G, (int)blockIdx.x);
                 pg8::EpiPlain<0> E{QK, 2048}; pg8::gemm_phase<pg8::EpiPlain<0>, pg8::StaticOrder, true, true>(lds, g, S, E); SEAM(9); }
    if (IN(10)) { pg8::Gemm g{(const bf16_t*)(ws + WS_WV), XB, 1024, M, 1024}; pg8::StaticOrder S; S.init(1024, M, G, (int)blockIdx.x);
                 pg8::EpiPlain<0> E{VT, M}; pg8::gemm_phase<pg8::EpiPlain<0>, pg8::StaticOrder, true, true>(lds, g, S, E); SEAM(10); }
    if (IN(11)) { AttnArgs a{QK, VT, AO, args.in[14], args.in[15], args.in[16], args.in[17], args.in[18]}; for (int rep = 0; rep < REP_ATTN; ++rep) attn_phase(lds, a, G); SEAM(11); }
    GEMM_RES(12, AO, WS_WO1, 1024, out)
    LNPH(13, 20, 21, 1)
    GEMM_UP(14, WS_WUP1)
    GEMM_RES(15, FF, WS_WDN1, 4096, out)
    LNPH(16, 22, 23, 1)
}

extern "C" void kernel_launch(void* const* d_in, const int* in_sizes, int n_in, void* d_out, int out_size, void* d_ws, size_t ws_size, hipStream_t stream) {
    static int grid = 0;
    if (grid == 0) {
        if (n_in != 26 || out_size != M * DM || ws_size < WS_END) { fprintf(stderr, "kernel_launch: unexpected shapes (n_in %d out %d ws %zu)\n", n_in, out_size, ws_size); grid = -1; return; }
        int dev = 0, cus = 0, per_cu = 0;
        hipGetDevice(&dev); hipDeviceGetAttribute(&cus, hipDeviceAttributeMultiprocessorCount, dev);
        if (hipFuncSetAttribute((const void*)mega_fwd, hipFuncAttributeMaxDynamicSharedMemorySize, LDS_BYTES) != hipSuccess) { fprintf(stderr, "kernel_launch: hipFuncSetAttribute failed\n"); grid = -1; return; }
        if (hipOccupancyMaxActiveBlocksPerMultiprocessor(&per_cu, (const void*)mega_fwd, NTHR, LDS_BYTES) != hipSuccess || per_cu < 1) { fprintf(stderr, "kernel_launch: occupancy query gives %d\n", per_cu); per_cu = 1; }
        (void)hipGetLastError();
        grid = cus * (per_cu > 1 ? 1 : per_cu);
        if (grid <= 0) grid = 256;
    }
    if (grid < 0) return;
    Args a{};
    for (int i = 0; i < 26; ++i) a.in[i] = (const float*)d_in[i];
    a.out = (float*)d_out; a.ws = (unsigned char*)d_ws; a.ph_lo = 0; a.ph_hi = NPHASE;
    if (hipMemsetAsync(d_ws, 0, 16384, stream) != hipSuccess) { fprintf(stderr, "kernel_launch: memset failed\n"); return; }
    void* kargs[] = {&a};
    hipError_t e = hipLaunchCooperativeKernel((const void*)mega_fwd, dim3(grid), dim3(NTHR), kargs, LDS_BYTES, stream);
    if (e != hipSuccess) fprintf(stderr, "kernel_launch: cooperative launch failed: %s (grid %d)\n", hipGetErrorString(e), grid);
}
```

```cpp
#include <hip/hip_runtime.h>
#include <hip/hip_cooperative_groups.h>
#include <cstdio>
#include <cstdint>
namespace cg = cooperative_groups;
#define LAS __attribute__((address_space(3)))
namespace pg8 {
#define PG8_LAS __attribute__((address_space(3)))
typedef unsigned short bf16_t;
typedef short bf16x8 __attribute__((ext_vector_type(8)));
typedef float f32x4 __attribute__((ext_vector_type(4)));
typedef unsigned u32x4 __attribute__((ext_vector_type(4)));
constexpr int BM = 256, BK = 64, HALF = 128, HTB = HALF * BK * 2  , STAGE_BYTES = 8 * HTB, NXCD = 8, WGM = 8;

__host__ __device__ __forceinline__ int lds_byte(int r, int c) { const int st = (r >> 4) * 2 + (c >> 5), rr = r & 15, cc = c & 31, ob = rr * 64 + cc * 2; return st * 1024 + (ob ^ (((ob >> 9) & 1) << 5)); }
__host__ __device__ __forceinline__ void stage_rc(int b, int& R, int& C) { const int st = b / 1024, sb = b % 1024, swz = sb ^ (((sb >> 9) & 1) << 5); R = (st >> 1) * 16 + swz / 64; C = (st & 1) * 32 + (swz % 64) / 2; }
__host__ __device__ __forceinline__ int perm32(int rho) { const int n = rho >> 4, i = rho & 15; return 8 * (i >> 2) + 4 * n + (i & 3); }

struct Unit { int pm, pn; };
struct Gemm { const bf16_t* A; const bf16_t* Bt; int M, N, K; };

struct StaticOrder {
    int nM, nN, nwg, G, c;
    __host__ __device__ void init(int M, int N, int G_, int c_) { nM = M / BM; nN = N / BM; nwg = nM * nN; G = G_; c = c_; }
    __host__ __device__ bool next(int i, Unit& u) const {
        const long L = (long)i * G + c; if (L >= nwg) return false;
        int wgid = (int)L; { const int q = nwg / NXCD, r = nwg % NXCD, xcd = wgid % NXCD, off = wgid / NXCD; wgid = (xcd < r ? xcd * (q + 1) : r * (q + 1) + (xcd - r) * q) + off; }
        const int nig = WGM * nN, gid = wgid / nig, fm = gid * WGM, gsz = (nM - fm) < WGM ? (nM - fm) : WGM;
        u.pm = fm + ((wgid % nig) % gsz); u.pn = (wgid % nig) / gsz; return true;
    }
    __device__ __forceinline__ void a_ready(const Unit&) const {}
    __device__ __forceinline__ void done(const Unit&) const {}
};
__device__ __forceinline__ unsigned cvt_pk_bf16(float lo, float hi) { unsigned r; asm volatile("v_cvt_pk_bf16_f32 %0, %1, %2" : "=v"(r) : "v"(lo), "v"(hi)); return r; }
typedef float f32x2 __attribute__((ext_vector_type(2)));
__device__ __forceinline__ f32x2 gelu_pk(f32x2 v) {
    const f32x2 av = __builtin_elementwise_abs(v), d = av * 0.2316418882f + 1.0f;
    f32x2 t; t.x = __builtin_amdgcn_rcpf(d.x); t.y = __builtin_amdgcn_rcpf(d.y);
    f32x2 q = t * 0.5307027145f + (-0.7265760135f); q = q * t + 0.7107068705f; q = q * t + (-0.142248368f); q = q * t + 0.127414796f; q = q * t;
    const f32x2 s = (v * v) * (-0.72134752044f);
    f32x2 e; e.x = __builtin_amdgcn_exp2f(s.x); e.y = __builtin_amdgcn_exp2f(s.y);
    const f32x2 m = v * (q * e), r = v - m;
    f32x2 o; o.x = v.x < 0.f ? m.x : r.x; o.y = v.y < 0.f ? m.y : r.y; return o;
}
typedef unsigned u32x4e __attribute__((ext_vector_type(4)));
template <int ACT  > struct EpiPlain {
    static constexpr bool PERM = true, AFTER_DRAIN = false;
    bf16_t* O; int ldc;
    __device__ __forceinline__ void operator()(const f32x4 (&acc)[2][2][4][2], const Unit& u, int wr, int wc, int fr, int fq) const {
        const int row0 = u.pm * BM + wr * 64 + fr, col0 = u.pn * BM + wc * 32 + 8 * fq;
#pragma unroll
        for (int ai = 0; ai < 2; ++ai)
#pragma unroll
            for (int m = 0; m < 4; ++m) { bf16_t* rowp = O + (size_t)(row0 + ai * HALF + m * 16) * ldc + col0;
#pragma unroll
                for (int bj = 0; bj < 2; ++bj) { f32x4 v0 = acc[ai][bj][m][0], v1 = acc[ai][bj][m][1];
                    if (ACT == 2) {
#pragma unroll
                        for (int e = 0; e < 4; ++e) { const float a = v0[e] > 0.f ? v0[e] : 0.f, b = v1[e] > 0.f ? v1[e] : 0.f; v0[e] = a * a; v1[e] = b * b; } }
                    u32x4e w; w.x = cvt_pk_bf16(v0[0], v0[1]); w.y = cvt_pk_bf16(v0[2], v0[3]); w.z = cvt_pk_bf16(v1[0], v1[1]); w.w = cvt_pk_bf16(v1[2], v1[3]);
                    *(u32x4e*)(rowp + bj * HALF) = w; } }
    }
};
struct EpiInProj {
    static constexpr bool PERM = true, AFTER_DRAIN = false;
    bf16_t *Z, *XBC, *UV; float* DT;
    __device__ __forceinline__ void operator()(const f32x4 (&acc)[2][2][4][2], const Unit& u, int wr, int wc, int fr, int fq) const {
        const int row0 = u.pm * BM + wr * 64 + fr;
        if (u.pn == 18) {
            if (wc == 0 && fq < 2) {
#pragma unroll
                for (int ai = 0; ai < 2; ++ai)
#pragma unroll
                    for (int m = 0; m < 4; ++m) { float* rp = DT + (size_t)(row0 + ai * HALF + m * 16) * 16 + 8 * fq;
                        *(f32x4*)(rp) = acc[ai][0][m][0]; *(f32x4*)(rp + 4) = acc[ai][0][m][1]; }
            }
            return;
        }
        bf16_t* base; int ldc, colt; bool act;
        if (u.pn < 4) { base = Z; ldc = 1024; colt = u.pn * BM; act = false; }
        else if (u.pn < 10) { base = XBC; ldc = 1536; colt = (u.pn - 4) * BM; act = false; }
        else { base = UV; ldc = 2048; colt = (u.pn - 10) * BM; act = true; }
        const int col0 = colt + wc * 32 + 8 * fq;
#pragma unroll
        for (int ai = 0; ai < 2; ++ai)
#pragma unroll
            for (int m = 0; m < 4; ++m) { bf16_t* rowp = base + (size_t)(row0 + ai * HALF + m * 16) * ldc + col0;
#pragma unroll
                for (int bj = 0; bj < 2; ++bj) { f32x4 v0 = acc[ai][bj][m][0], v1 = acc[ai][bj][m][1];
                    if (act) { f32x2 a = gelu_pk((f32x2){v0[0], v0[1]}), b = gelu_pk((f32x2){v0[2], v0[3]}), c = gelu_pk((f32x2){v1[0], v1[1]}), d = gelu_pk((f32x2){v1[2], v1[3]});
                        v0 = (f32x4){a.x, a.y, b.x, b.y}; v1 = (f32x4){c.x, c.y, d.x, d.y}; }
                    u32x4e w; w.x = cvt_pk_bf16(v0[0], v0[1]); w.y = cvt_pk_bf16(v0[2], v0[3]); w.z = cvt_pk_bf16(v1[0], v1[1]); w.w = cvt_pk_bf16(v1[2], v1[3]);
                    *(u32x4e*)(rowp + bj * HALF) = w; } }
    }
};
struct EpiRes {
    static constexpr bool PERM = false, AFTER_DRAIN = false;
    const float* base; float* out; float alpha;
    __device__ __forceinline__ void operator()(const f32x4 (&acc)[2][2][4][2], const Unit& u, int wr, int wc, int fr, int fq) const {
        const int row0 = u.pm * BM + wr * 64 + fr, col0 = u.pn * BM + wc * 32 + 4 * fq;
#pragma unroll
        for (int ai = 0; ai < 2; ++ai)
#pragma unroll
            for (int m = 0; m < 4; ++m) { const size_t off = (size_t)(row0 + ai * HALF + m * 16) * 1024 + col0;
#pragma unroll
                for (int bj = 0; bj < 2; ++bj)
#pragma unroll
                    for (int n = 0; n < 2; ++n) { const f32x4 bs = *(const f32x4*)(base + off + bj * HALF + n * 16);
                        *(f32x4*)(out + off + bj * HALF + n * 16) = bs * alpha + acc[ai][bj][m][n]; } }
    }
};
template <class Epi, class Sched, bool ALIGN_EPI = false, bool SP2 = false>
__device__ __forceinline__ void gemm_phase(PG8_LAS unsigned char* lds, const Gemm g, const Sched& S, const Epi& E) {
    const int tid = threadIdx.x, wid = __builtin_amdgcn_readfirstlane(tid >> 6), lane = tid & 63, wr = wid >> 2, wc = wid & 3, fr = lane & 15, fq = lane >> 4;
    const int K = g.K, nt = K / BK;
    unsigned voffA[2], voffB[2];
#pragma unroll
    for (int i = 0; i < 2; ++i) { int R, C; stage_rc(tid * 16 + i * 8192, R, C); const int Rb = Epi::PERM ? ((R & ~31) + perm32(R & 31)) : R;
        voffA[i] = (unsigned)(R * K + C) * 2u; voffB[i] = (unsigned)(Rb * K + C) * 2u; }
    const size_t kstep = (size_t)(BK * 2);
    const size_t hstep = (size_t)HALF * K * 2;
    const size_t tstep = 2 * hstep;
    const unsigned ldsw = (unsigned)wid * 1024u;
    const int aoff = lds_byte(wr * 64 + fr, fq * 8), boff = lds_byte(wc * 32 + fr, fq * 8);
#define PG8_SA(b, h) (((b) * 2 + (h)) * HTB)
#define PG8_SB(b, h) ((4 + (b) * 2 + (h)) * HTB)
#define PG8_STAGE(bufoff, gbase, voff) do { _Pragma("unroll") for (int _i = 0; _i < 2; ++_i) \
        __builtin_amdgcn_global_load_lds((const unsigned*)((const char*)(gbase) + (voff)[_i]), (PG8_LAS unsigned*)(lds + (bufoff) + ldsw + _i * 8192), 16, 0, 0); } while (0)
#define PG8_LDA(dst, b, h) do { _Pragma("unroll") for (int m = 0; m < 4; ++m) _Pragma("unroll") for (int k = 0; k < 2; ++k) dst[m][k] = *(const PG8_LAS bf16x8*)(lds + PG8_SA(b, h) + aoff + m * 2048 + k * 1024); } while (0)
#define PG8_LDB(dst, b, h) do { _Pragma("unroll") for (int n = 0; n < 2; ++n) _Pragma("unroll") for (int k = 0; k < 2; ++k) dst[n][k] = *(const PG8_LAS bf16x8*)(lds + PG8_SB(b, h) + boff + n * 2048 + k * 1024); } while (0)
#define PG8_MMA(ai, bj, At, Bt) do { __builtin_amdgcn_s_setprio(1); _Pragma("unroll") for (int m = 0; m < 4; ++m) _Pragma("unroll") for (int n = 0; n < 2; ++n) _Pragma("unroll") for (int k = 0; k < 2; ++k) \
        acc[ai][bj][m][n] = __builtin_amdgcn_mfma_f32_16x16x32_bf16(Bt[n][k], At[m][k], acc[ai][bj][m][n], 0, 0, 0); __builtin_amdgcn_s_setprio(0); } while (0)
#define PG8_WAIT_V(n) asm volatile("s_waitcnt vmcnt(" #n ")" ::: "memory")
#define PG8_WAIT_L(n) asm volatile("s_waitcnt lgkmcnt(" #n ")" ::: "memory")
#define PG8_BAR __builtin_amdgcn_s_barrier()
#define PG8_SCHED __builtin_amdgcn_sched_barrier(0)
    Unit cur, nxt; int ui = 0;
    if (!S.next(0, cur)) return;
    f32x4 acc[2][2][4][2];
#pragma unroll
    for (int a = 0; a < 2; ++a)
#pragma unroll
        for (int b = 0; b < 2; ++b)
#pragma unroll
            for (int m = 0; m < 4; ++m)
#pragma unroll
                for (int n = 0; n < 2; ++n) acc[a][b][m][n] = (f32x4){0.f, 0.f, 0.f, 0.f};
    bf16x8 At[4][2], B0[2][2], B1[2][2];
    const char* cA = (const char*)g.A + (size_t)cur.pm * tstep; const char* cB = (const char*)g.Bt + (size_t)cur.pn * tstep;
    S.a_ready(cur);
    if constexpr (SP2) {
        PG8_STAGE(PG8_SB(0, 0), cB, voffB); PG8_STAGE(PG8_SB(0, 1), cB + hstep, voffB); PG8_STAGE(PG8_SA(0, 0), cA, voffA); PG8_STAGE(PG8_SA(0, 1), cA + hstep, voffA);
        if (wr == 1) PG8_BAR;
        PG8_WAIT_V(2); PG8_BAR;
        PG8_STAGE(PG8_SB(1, 0), cB + kstep, voffB); PG8_STAGE(PG8_SA(1, 0), cA + kstep, voffA); PG8_STAGE(PG8_SB(1, 1), cB + hstep + kstep, voffB);
        PG8_WAIT_V(6); PG8_BAR;
    } else {
        PG8_STAGE(PG8_SB(0, 0), cB, voffB); PG8_STAGE(PG8_SA(0, 0), cA, voffA); PG8_STAGE(PG8_SB(0, 1), cB + hstep, voffB); PG8_STAGE(PG8_SA(0, 1), cA + hstep, voffA);
        if (wr == 1) PG8_BAR;
        PG8_WAIT_V(4); PG8_BAR;
        PG8_STAGE(PG8_SB(1, 0), cB + kstep, voffB); PG8_STAGE(PG8_SA(1, 0), cA + kstep, voffA); PG8_STAGE(PG8_SB(1, 1), cB + hstep + kstep, voffB);
        PG8_WAIT_V(6); PG8_BAR;
    }
    for (;;) {
        const bool has_next = S.next(ui + 1, nxt);
        const char* nA = has_next ? (const char*)g.A + (size_t)nxt.pm * tstep : cA; const char* nB = has_next ? (const char*)g.Bt + (size_t)nxt.pn * tstep : cB;
        for (int t = 0; t < nt; t += 2) {
            const bool last = (t == nt - 2);
            const char* a1 = cA + (size_t)(t + 1) * kstep;
            const char* a2 = last ? nA : cA + (size_t)(t + 2) * kstep; const char* b2 = last ? nB : cB + (size_t)(t + 2) * kstep;
            const char* a3 = a2 + kstep; const char* b3 = b2 + kstep;
            if (last && has_next) S.a_ready(nxt);
            if constexpr (SP2) {
            PG8_LDB(B0, 0, 0); PG8_LDB(B1, 0, 1); PG8_SCHED; PG8_LDA(At, 0, 0); PG8_STAGE(PG8_SA(1, 1), a1 + hstep, voffA);
            PG8_WAIT_V(8); PG8_WAIT_L(0); PG8_BAR; PG8_MMA(0, 0, At, B0); PG8_MMA(0, 1, At, B1); PG8_BAR; PG8_SCHED;
            PG8_LDA(At, 0, 1); PG8_STAGE(PG8_SB(0, 0), b2, voffB); PG8_STAGE(PG8_SB(0, 1), b2 + hstep, voffB); PG8_STAGE(PG8_SA(0, 0), a2, voffA);
            PG8_WAIT_V(8); PG8_WAIT_L(0); PG8_BAR; PG8_MMA(1, 0, At, B0); PG8_MMA(1, 1, At, B1); PG8_BAR; PG8_SCHED;
            PG8_LDB(B0, 1, 0); PG8_LDB(B1, 1, 1); PG8_SCHED; PG8_LDA(At, 1, 0); PG8_STAGE(PG8_SA(0, 1), a2 + hstep, voffA);
            PG8_WAIT_V(8); PG8_WAIT_L(0); PG8_BAR; PG8_MMA(0, 0, At, B0); PG8_MMA(0, 1, At, B1); PG8_BAR; PG8_SCHED;
            PG8_LDA(At, 1, 1); PG8_STAGE(PG8_SB(1, 0), b3, voffB); PG8_STAGE(PG8_SB(1, 1), b3 + hstep, voffB); PG8_STAGE(PG8_SA(1, 0), a3, voffA);
            PG8_WAIT_V(8); PG8_WAIT_L(0); PG8_BAR; PG8_MMA(1, 0, At, B0); PG8_MMA(1, 1, At, B1); PG8_BAR; PG8_SCHED;
            } else {
            PG8_LDB(B0, 0, 0); PG8_SCHED; PG8_LDA(At, 0, 0); PG8_STAGE(PG8_SA(1, 1), a1 + hstep, voffA);
            PG8_WAIT_L(8); PG8_BAR; PG8_WAIT_L(0); PG8_MMA(0, 0, At, B0); PG8_BAR; PG8_SCHED;
            PG8_LDB(B1, 0, 1); PG8_STAGE(PG8_SB(0, 0), b2, voffB);
            PG8_BAR; PG8_WAIT_L(0); PG8_MMA(0, 1, At, B1); PG8_BAR;
            PG8_LDA(At, 0, 1); PG8_STAGE(PG8_SA(0, 0), a2, voffA);
            PG8_BAR; PG8_WAIT_L(0); PG8_MMA(1, 0, At, B0); PG8_BAR; PG8_SCHED;
            PG8_STAGE(PG8_SB(0, 1), b2 + hstep, voffB);
            PG8_WAIT_V(6); PG8_BAR; PG8_MMA(1, 1, At, B1); PG8_BAR;
            PG8_LDB(B0, 1, 0); PG8_SCHED; PG8_LDA(At, 1, 0); PG8_STAGE(PG8_SA(0, 1), a2 + hstep, voffA);
            PG8_WAIT_L(8); PG8_BAR; PG8_WAIT_L(0); PG8_MMA(0, 0, At, B0); PG8_BAR; PG8_SCHED;
            PG8_LDB(B1, 1, 1); PG8_STAGE(PG8_SB(1, 0), b3, voffB);
            PG8_BAR; PG8_WAIT_L(0); PG8_MMA(0, 1, At, B1); PG8_BAR;
            PG8_LDA(At, 1, 1); PG8_STAGE(PG8_SA(1, 0), a3, voffA);
            PG8_BAR; PG8_WAIT_L(0); PG8_MMA(1, 0, At, B0); PG8_BAR; PG8_SCHED;
            PG8_STAGE(PG8_SB(1, 1), b3 + hstep, voffB);
            PG8_WAIT_V(6); PG8_BAR; PG8_MMA(1, 1, At, B1); PG8_BAR;
            }
        }
        if constexpr (ALIGN_EPI) { if (wr == 0) PG8_BAR; }
        if constexpr (!Epi::AFTER_DRAIN) { E(acc, cur, wr, wc, fr, fq); S.done(cur); }
        if (!has_next) break;
#pragma unroll
        for (int a = 0; a < 2; ++a)
#pragma unroll
            for (int b = 0; b < 2; ++b)
#pragma unroll
                for (int m = 0; m < 4; ++m)
#pragma unroll
                    for (int n = 0; n < 2; ++n) acc[a][b][m][n] = (f32x4){0.f, 0.f, 0.f, 0.f};
        cur = nxt; cA = nA; cB = nB; ++ui;
        if constexpr (ALIGN_EPI) { if (wr == 1) PG8_BAR; }
    }
    PG8_WAIT_V(0);
    if constexpr (!ALIGN_EPI) { if (wr == 0) PG8_BAR; }
    PG8_BAR;
    if constexpr (Epi::AFTER_DRAIN) { E.fused(acc, cur, wr, wc, fr, fq, lds, wid, lane); S.done(cur); }
#undef PG8_SA
#undef PG8_SB
#undef PG8_STAGE
#undef PG8_LDA
#undef PG8_LDB
#undef PG8_MMA
#undef PG8_WAIT_V
#undef PG8_WAIT_L
#undef PG8_BAR
#undef PG8_SCHED
}
}
#define XB_TMO      128
#define XB_XCNT(j)  (256  + 64 * (j))
#define XB_XSUB(j)  (1280 + 64 * (j))
#define XB_XGEN(j)  (2304 + 64 * (j))
#define XB_TOP      3328
#define XB_TOPGEN   3392
#define XCD_BAR_WORDS 3456
#define XB_SPIN_CAP (1u << 18)

__device__ __forceinline__ unsigned xb_ld(unsigned* p)              { return __hip_atomic_load(p, __ATOMIC_RELAXED, __HIP_MEMORY_SCOPE_AGENT); }
__device__ __forceinline__ unsigned xb_add(unsigned* p, unsigned v) { return __hip_atomic_fetch_add(p, v, __ATOMIC_RELAXED, __HIP_MEMORY_SCOPE_AGENT); }
__device__ __forceinline__ unsigned xb_xcc_id() { return (unsigned)__builtin_amdgcn_s_getreg((3 << 11) | 20) & 0xFu; }
#define XB_SPIN(cond, bar) do { unsigned _sp = 0; while (cond) { __builtin_amdgcn_s_sleep(1); \
    if ((++_sp & 255u) == 0u) { if (xb_ld(&(bar)[XB_TMO])) break; if (_sp > XB_SPIN_CAP) { atomicAdd(&(bar)[XB_TMO], 1u); break; } } } } while (0)

struct XcdBarrier {
    unsigned* bar; unsigned x;
    volatile LAS unsigned* st;
};

__device__ __forceinline__ XcdBarrier xcd_barrier_post(unsigned* bar, volatile LAS unsigned* st) {
    XcdBarrier b; b.bar = bar; b.x = xb_xcc_id(); b.st = st;
    if (threadIdx.x == 0) (void)xb_add(&bar[XB_XCNT(b.x)], 1u);
    return b;
}
__device__ __forceinline__ void xcd_barrier_complete(unsigned* bar, unsigned x, unsigned& nloc, unsigned& nx) {
    const unsigned G = gridDim.x * gridDim.y * gridDim.z;
    unsigned sum, cnt, mine, sp = 0u;
    for (;;) {
        sum = 0u; cnt = 0u; mine = 0u;
#pragma unroll
        for (unsigned j = 0; j < 16; ++j) { const unsigned c = xb_ld(&bar[XB_XCNT(j)]); sum += c; cnt += (c > 0u) ? 1u : 0u; mine = (j == x) ? c : mine; }
        if (sum == G) break;
        __builtin_amdgcn_s_sleep(1);
        if ((++sp & 255u) == 0u) { if (xb_ld(&bar[XB_TMO])) break; if (sp > XB_SPIN_CAP) { atomicAdd(&bar[XB_TMO], 1u); break; } }
    }
    nloc = mine > 0u ? mine : 1u; nx = cnt > 0u ? cnt : 1u;
}

__device__ __forceinline__ void xcd_barrier(const XcdBarrier& b) {
    asm volatile("s_waitcnt vmcnt(0)" ::: "memory");
    __syncthreads();
    if (threadIdx.x == 0) {
        unsigned* bar = b.bar;
        __builtin_amdgcn_s_waitcnt(0);
        unsigned nloc = b.st[0], nx = b.st[1];
        if (nloc == 0u) { xcd_barrier_complete(bar, b.x, nloc, nx); b.st[0] = nloc; b.st[1] = nx; }
        const unsigned old = xb_add(&bar[XB_XSUB(b.x)], 1u);
        const unsigned gen = old / nloc;
        if (old + 1u == (gen + 1u) * nloc) {
            __builtin_amdgcn_fence(__ATOMIC_RELEASE, "agent");
            asm volatile("s_waitcnt vmcnt(0)" ::: "memory");
            const unsigned og = xb_add(&bar[XB_TOP], 1u);
            const unsigned tg = og / nx;
            if (og + 1u == (tg + 1u) * nx) xb_add(&bar[XB_TOPGEN], 1u);
            else XB_SPIN(xb_ld(&bar[XB_TOPGEN]) == tg, bar);
            __builtin_amdgcn_fence(__ATOMIC_ACQUIRE, "agent");
            xb_add(&bar[XB_XGEN(b.x)], 1u);
            asm volatile("s_waitcnt vmcnt(0)" ::: "memory");
        } else {
            XB_SPIN(xb_ld(&bar[XB_XGEN(b.x)]) == gen, bar);
            __builtin_amdgcn_fence(__ATOMIC_ACQUIRE, "agent");
            asm volatile("s_waitcnt vmcnt(0)" ::: "memory");
        }
    }
    __syncthreads();
}

#define LAS __attribute__((address_space(3)))
typedef unsigned short bf16_t;
typedef short bf16x8 __attribute__((ext_vector_type(8)));
typedef float f32x4 __attribute__((ext_vector_type(4)));
typedef float f32x16 __attribute__((ext_vector_type(16)));
typedef unsigned u32x4 __attribute__((ext_vector_type(4)));
typedef unsigned u32x2 __attribute__((ext_vector_type(2)));
typedef float f32x2_t __attribute__((ext_vector_type(2)));
typedef __bf16 bf16x2_t __attribute__((ext_vector_type(2)));

constexpr int M = 32768, SEQ = 4096, DM = 1024, NB = 8;
constexpr int NWAVES = 8, NTHR = 512;
constexpr int LDS_BYTES = 147456;
constexpr float LN_EPS = 1e-5f;
constexpr float ALPHA = 1.4142135623730951f;
constexpr float LOG2E = 1.4426950408889634f;
constexpr float QSCALE = 0.125f * LOG2E;
constexpr float LAMBDA_INIT = 0.8f - 0.6f * 0.7408182206817179f;
constexpr int NPHASE = 17;
#ifndef REP_SYNC
#define REP_SYNC 1
#endif
#ifndef REP_P0
#define REP_P0 1
#endif
#ifndef REP_SSD
#define REP_SSD 1
#endif
#ifndef REP_ATTN
#define REP_ATTN 1
#endif
#ifndef REP_MIX
#define REP_MIX 1
#endif

constexpr size_t MiB = 1u << 20;
constexpr size_t WS_WIN = 1 * MiB, WS_WOUT0 = 11 * MiB, WS_WUP0 = 15 * MiB, WS_WDN0 = 23 * MiB, WS_WQK = 31 * MiB, WS_WV = 35 * MiB,
                 WS_WO1 = 37 * MiB, WS_WUP1 = 39 * MiB, WS_WDN1 = 47 * MiB, WS_SGUW = 55 * MiB;
constexpr size_t WS_XB = 64 * MiB;
constexpr size_t WS_BIG = 128 * MiB;
constexpr size_t WS_XBC = 384 * MiB;
constexpr size_t WS_DT = 480 * MiB;
constexpr size_t WS_END = 482 * MiB;

__device__ __forceinline__ unsigned pk2(float lo, float hi) { f32x2_t v = {lo, hi}; bf16x2_t b = __builtin_convertvector(v, bf16x2_t); return __builtin_bit_cast(unsigned, b); }
__device__ __forceinline__ float bflo(unsigned u) { return __uint_as_float(u << 16); }
__device__ __forceinline__ float bfhi(unsigned u) { return __uint_as_float(u & 0xffff0000u); }
__device__ __forceinline__ float bf2f(bf16_t h) { return __uint_as_float((unsigned)h << 16); }
__device__ __forceinline__ bf16_t f2bf(float f) { return (bf16_t)(pk2(f, 0.f) & 0xffffu); }
__device__ __forceinline__ float wave_sum(float v) {
#pragma unroll
    for (int o = 1; o < 64; o <<= 1) v += __shfl_xor(v, o);
    return v;
}
__device__ __forceinline__ float sigmoidf_(float x) { return 1.0f / (1.0f + __expf(-x)); }
#define MFMA16(a, b, c) __builtin_amdgcn_mfma_f32_16x16x32_bf16((a), (b), (c), 0, 0, 0)
#define MFMA32(a, b, c) __builtin_amdgcn_mfma_f32_32x32x16_bf16((a), (b), (c), 0, 0, 0)

__device__ __forceinline__ void tr_item(const float* W, int ld, int c0, bf16_t* WT, int K, int row0, float scale, LAS float* scr, int kb, int nb, int lane) {
    const int k0 = 64 * kb, n0 = 32 * nb;
#pragma unroll 8
    for (int i = 0; i < 32; ++i) { const int kk = 2 * i + (lane >> 5); scr[kk * 33 + (lane & 31)] = W[(size_t)(k0 + kk) * ld + c0 + n0 + (lane & 31)] * scale; }
    asm volatile("s_waitcnt lgkmcnt(0)" ::: "memory");
    const int c = lane & 7;
#pragma unroll
    for (int j = 0; j < 4; ++j) { const int n = (lane >> 3) + 8 * j; const LAS float* s = scr + (8 * c) * 33 + n;
        u32x4 o; o.x = pk2(s[0 * 33], s[1 * 33]); o.y = pk2(s[2 * 33], s[3 * 33]); o.z = pk2(s[4 * 33], s[5 * 33]); o.w = pk2(s[6 * 33], s[7 * 33]);
        *(u32x4*)(WT + (size_t)(row0 + n0 + n) * K + k0 + 8 * c) = o; }
    asm volatile("s_waitcnt lgkmcnt(0)" ::: "memory");
}
struct P0Args { const float *x, *w_in, *w_out0, *w_up, *w_dn, *w_qkv, *w_o1, *sgu_w; unsigned char* ws; };
__device__ __forceinline__ void p0_prologue(LAS unsigned char* lds, const P0Args& a, int G) {
    const int tid = threadIdx.x, lane = tid & 63, wid = __builtin_amdgcn_readfirstlane(tid >> 6);
    LAS float* scr = (LAS float*)(lds + wid * 16384);
    const int gw = blockIdx.x * NWAVES + wid, NGW = G * NWAVES;
    bf16_t* WIN = (bf16_t*)(a.ws + WS_WIN);
#define TR_MAT(src, ld, c0, ncols, dst, K, row0, scale) { const int nblk = (ncols) / 32, nit = ((K) / 64) * nblk; \
        if (r < nit) { tr_item((src), (ld), (c0), (dst), (K), (row0), (scale), scr, r / nblk, r % nblk, lane); continue; } r -= nit; }
    constexpr int NIT = 16 * 80 + 16 * 64 + 32 * 32 + 2 * (16 * 128) + 2 * (64 * 32) + 16 * 32 + 16 * 32 + 16 * 32 + 16 * 32;
    for (int it = gw; it < NIT; it += NGW) {
        int r = it;
        TR_MAT(a.w_in, 4624, 0, 2560, WIN, 1024, 0, 1.f)
        TR_MAT(a.w_in, 4624, 2576, 2048, WIN, 1024, 2560, 1.f)
        TR_MAT(a.w_out0, 1024, 0, 1024, (bf16_t*)(a.ws + WS_WOUT0), 2048, 0, 1.f)
        TR_MAT(a.w_up, 4096, 0, 4096, (bf16_t*)(a.ws + WS_WUP0), 1024, 0, 1.f)
        TR_MAT(a.w_up + (size_t)1024 * 4096, 4096, 0, 4096, (bf16_t*)(a.ws + WS_WUP1), 1024, 0, 1.f)
        TR_MAT(a.w_dn, 1024, 0, 1024, (bf16_t*)(a.ws + WS_WDN0), 4096, 0, 1.f)
        TR_MAT(a.w_dn + (size_t)4096 * 1024, 1024, 0, 1024, (bf16_t*)(a.ws + WS_WDN1), 4096, 0, 1.f)
        TR_MAT(a.w_qkv, 3072, 0, 1024, (bf16_t*)(a.ws + WS_WQK), 1024, 0, QSCALE)
        TR_MAT(a.w_qkv, 3072, 1024, 1024, (bf16_t*)(a.ws + WS_WQK), 1024, 1024, 1.f)
        TR_MAT(a.w_qkv, 3072, 2048, 1024, (bf16_t*)(a.ws + WS_WV), 1024, 0, 1.f)
        TR_MAT(a.w_o1, 1024, 0, 1024, (bf16_t*)(a.ws + WS_WO1), 1024, 0, 1.f)
    }
#undef TR_MAT
    const size_t gt = (size_t)blockIdx.x * NTHR + tid, NGT = (size_t)G * NTHR;
    for (size_t i = gt; i < (size_t)256 * 1024; i += NGT) { const int n = (int)(i >> 10), k = (int)(i & 1023);
        WIN[(size_t)(4608 + n) * 1024 + k] = n < 16 ? f2bf(a.w_in[(size_t)k * 4624 + 2560 + n]) : (bf16_t)0; }
    bf16_t* SW = (bf16_t*)(a.ws + WS_SGUW);
    for (size_t i = gt; i < (size_t)8 * 128 * 128; i += NGT) { const int s = (int)(i & 127), t = (int)((i >> 7) & 127);
        SW[i] = ((t >> 6) >= (s >> 6)) ? f2bf(a.sgu_w[i]) : (bf16_t)0; }
    bf16_t* XB = (bf16_t*)(a.ws + WS_XB);
    for (size_t i = gt; i < (size_t)M * DM / 8; i += NGT) { const f32x4 v0 = *(const f32x4*)(a.x + i * 8), v1 = *(const f32x4*)(a.x + i * 8 + 4);
        u32x4 o; o.x = pk2(v0[0], v0[1]); o.y = pk2(v0[2], v0[3]); o.z = pk2(v1[0], v1[1]); o.w = pk2(v1[2], v1[3]); *(u32x4*)(XB + i * 8) = o; }
}

__device__ __forceinline__ void ln_phase(float* buf, bf16_t* xb, const float* g, const float* b, int G) {
    const int tid = threadIdx.x, lane = tid & 63, wid = tid >> 6;
    const int gw = blockIdx.x * NWAVES + wid, NGW = G * NWAVES;
    f32x4 gv[4], bv[4];
#pragma unroll
    for (int j = 0; j < 4; ++j) { gv[j] = *(const f32x4*)(g + lane * 4 + 256 * j); bv[j] = *(const f32x4*)(b + lane * 4 + 256 * j); }
    for (int m = gw; m < M; m += NGW) {
        float* row = buf + (size_t)m * DM + lane * 4;
        f32x4 v[4]; float s = 0.f;
#pragma unroll
        for (int j = 0; j < 4; ++j) { v[j] = *(const f32x4*)(row + 256 * j); s += (v[j][0] + v[j][1]) + (v[j][2] + v[j][3]); }
        const float mean = wave_sum(s) * (1.f / DM); float s2 = 0.f;
#pragma unroll
        for (int j = 0; j < 4; ++j) { v[j] = v[j] - mean; s2 += (v[j][0] * v[j][0] + v[j][1] * v[j][1]) + (v[j][2] * v[j][2] + v[j][3] * v[j][3]); }
        const float rstd = 1.f / sqrtf(wave_sum(s2) * (1.f / DM) + LN_EPS);
        bf16_t* xr = xb + (size_t)m * DM + lane * 4;
#pragma unroll
        for (int j = 0; j < 4; ++j) { const f32x4 o = v[j] * rstd * gv[j] + bv[j]; *(f32x4*)(row + 256 * j) = o;
            u32x2 w; w.x = pk2(o[0], o[1]); w.y = pk2(o[2], o[3]); *(u32x2*)(xr + 256 * j) = w; }
    }
}

struct SsdArgs { const bf16_t* XBC; const float* DT; bf16_t* Y; const float *conv_w, *conv_b, *dt_bias, *a_log, *d_skip; };
__device__ __forceinline__ void ssd_load(u32x4 (&raw)[7], const bf16_t* XBC, int b, int c, int rr, int colg) {
#pragma unroll
    for (int i = 0; i < 7; ++i) { const int tr = c * 64 + 4 * rr - 3 + i;
        raw[i] = tr >= 0 ? *(const u32x4*)(XBC + (size_t)(b * SEQ + tr) * 1536 + colg) : (u32x4){0u, 0u, 0u, 0u}; }
}
__device__ __forceinline__ void ssd_conv_task(const u32x4 (&raw)[7], int cgi, int rr, const float (&wj)[4], LAS float* CW, LAS bf16_t* Bs, LAS bf16_t* Cs, LAS bf16_t* BsT,
                                              LAS bf16_t* xT, LAS bf16_t* xwT, LAS float* xs) {
    u32x4 pack[4];
#pragma unroll
    for (int ep = 0; ep < 4; ++ep) {
        float i0[7], i1[7];
#pragma unroll
        for (int i = 0; i < 7; ++i) { const unsigned u = raw[i][ep]; i0[i] = bflo(u); i1[i] = bfhi(u); }
        const int lc = cgi * 8 + 2 * ep;
        float w0[5], w1[5];
#pragma unroll
        for (int k = 0; k < 5; ++k) { w0[k] = CW[k * 288 + lc]; w1[k] = CW[k * 288 + lc + 1]; }
        float o0[4], o1[4];
#pragma unroll
        for (int j = 0; j < 4; ++j) { float a = w0[4], c = w1[4];
#pragma unroll
            for (int k = 0; k < 4; ++k) { a += w0[k] * i0[j + k]; c += w1[k] * i1[j + k]; }
            o0[j] = a * sigmoidf_(a); o1[j] = c * sigmoidf_(c); }
#pragma unroll
        for (int j = 0; j < 4; ++j) pack[j][ep] = pk2(o0[j], o1[j]);
        if (cgi < 4) {
            const int p = cgi * 8 + 2 * ep;
#pragma unroll
            for (int j = 0; j < 4; ++j) { xs[(4 * rr + j) * 33 + p] = o0[j]; xs[(4 * rr + j) * 33 + p + 1] = o1[j]; }
            *(LAS u32x2*)(xT + p * 72 + 4 * rr) = (u32x2){pk2(o0[0], o0[1]), pk2(o0[2], o0[3])};
            *(LAS u32x2*)(xT + (p + 1) * 72 + 4 * rr) = (u32x2){pk2(o1[0], o1[1]), pk2(o1[2], o1[3])};
            *(LAS u32x2*)(xwT + p * 72 + 4 * rr) = (u32x2){pk2(o0[0] * wj[0], o0[1] * wj[1]), pk2(o0[2] * wj[2], o0[3] * wj[3])};
            *(LAS u32x2*)(xwT + (p + 1) * 72 + 4 * rr) = (u32x2){pk2(o1[0] * wj[0], o1[1] * wj[1]), pk2(o1[2] * wj[2], o1[3] * wj[3])};
        } else if (cgi < 20) {
            const int n = (cgi - 4) * 8 + 2 * ep;
            *(LAS u32x2*)(BsT + n * 72 + 4 * rr) = (u32x2){pk2(o0[0], o0[1]), pk2(o0[2], o0[3])};
            *(LAS u32x2*)(BsT + (n + 1) * 72 + 4 * rr) = (u32x2){pk2(o1[0], o1[1]), pk2(o1[2], o1[3])};
        }
    }
    if (cgi >= 4 && cgi < 20) {
#pragma unroll
        for (int j = 0; j < 4; ++j) *(LAS u32x4*)(Bs + (4 * rr + j) * 136 + (cgi - 4) * 8) = pack[j];
    } else if (cgi >= 20) {
#pragma unroll
        for (int j = 0; j < 4; ++j) *(LAS u32x4*)(Cs + (4 * rr + j) * 136 + (cgi - 20) * 8) = pack[j];
    }
}
__device__ __forceinline__ void ssd_phase(LAS unsigned char* lds, const SsdArgs& A, int G) {
    const int tid = threadIdx.x, lane = tid & 63, wid = __builtin_amdgcn_readfirstlane(tid >> 6), l15 = lane & 15, quad = lane >> 4;
    LAS float* CW = (LAS float*)(lds);
    LAS float* DTS = (LAS float*)(lds + 6144);
    LAS bf16_t* Bs = (LAS bf16_t*)(lds + 8192);
    LAS bf16_t* Cs = Bs + 64 * 136;
    LAS bf16_t* BsT = Cs + 64 * 136;
    LAS bf16_t* xT = BsT + 128 * 72;
    LAS bf16_t* xwT = xT + 32 * 72;
    LAS bf16_t* Lm = xwT + 32 * 72;
    LAS bf16_t* St = Lm + 64 * 72;
    LAS float* xs = (LAS float*)(St + 32 * 136);
    for (int item = blockIdx.x; item < 256; item += G) {
        const int b = item >> 5, h = (item >> 1) & 15, ph = item & 1, g = h >> 3;
        __syncthreads();
        for (int idx = tid; idx < 5 * 288; idx += NTHR) { const int k = idx / 288, lc = idx % 288;
            const int col = lc < 32 ? h * 64 + ph * 32 + lc : (lc < 160 ? 1024 + g * 128 + (lc - 32) : 1280 + g * 128 + (lc - 160));
            CW[idx] = k < 4 ? A.conv_w[k * 1536 + col] : A.conv_b[col]; }
        for (int idx = tid; idx < 32 * 136 / 2; idx += NTHR) ((LAS unsigned*)St)[idx] = 0u;
        const float a_h = -__expf(A.a_log[h]), dtb = A.dt_bias[h], Dh = A.d_skip[h];
        const int cg0 = tid % 36, rr0 = tid / 36, cg1 = (tid + 512) % 36, rr1 = (tid + 512) / 36;
        const int colg0 = cg0 < 4 ? h * 64 + ph * 32 + cg0 * 8 : (cg0 < 20 ? 1024 + g * 128 + (cg0 - 4) * 8 : 1280 + g * 128 + (cg0 - 20) * 8);
        const int colg1 = cg1 < 4 ? h * 64 + ph * 32 + cg1 * 8 : (cg1 < 20 ? 1024 + g * 128 + (cg1 - 4) * 8 : 1280 + g * 128 + (cg1 - 20) * 8);
        u32x4 raw0[7], raw1[7]; float dtraw;
        ssd_load(raw0, A.XBC, b, 0, rr0, colg0);
        if (tid < 64) ssd_load(raw1, A.XBC, b, 0, rr1, colg1);
        dtraw = A.DT[(size_t)(b * SEQ + lane) * 16 + h];
        f32x4 state[2]; state[0] = (f32x4){0.f, 0.f, 0.f, 0.f}; state[1] = (f32x4){0.f, 0.f, 0.f, 0.f};
        __syncthreads();
        for (int c = 0; c < 64; ++c) {
            const int rowbase = b * SEQ + c * 64;
            const float xdt = dtraw + dtb; const float dtv = xdt > 20.f ? xdt : log1pf(__expf(xdt));
            float acs = dtv * a_h;
#pragma unroll
            for (int off = 1; off < 64; off <<= 1) { const float t = __shfl_up(acs, off); if (lane >= off) acs += t; }
            const float acs63 = __shfl(acs, 63);
            const float wl = dtv * __expf(acs63 - acs);
            if (wid == 0) { DTS[lane] = dtv; DTS[64 + lane] = acs; DTS[128 + lane] = __expf(acs); }
            float wj0[4], wj1[4];
#pragma unroll
            for (int j = 0; j < 4; ++j) { wj0[j] = __shfl(wl, (4 * rr0 + j) & 63); wj1[j] = __shfl(wl, (4 * rr1 + j) & 63); }
            ssd_conv_task(raw0, cg0, rr0, wj0, CW, Bs, Cs, BsT, xT, xwT, xs);
            if (tid < 64) ssd_conv_task(raw1, cg1, rr1, wj1, CW, Bs, Cs, BsT, xT, xwT, xs);
            __syncthreads();
            if (c < 63) { ssd_load(raw0, A.XBC, b, c + 1, rr0, colg0); if (tid < 64) ssd_load(raw1, A.XBC, b, c + 1, rr1, colg1);
                dtraw = A.DT[(size_t)(rowbase + 64 + lane) * 16 + h]; }
            { const int ti = wid & 3, sjb = (wid >> 2) * 2;
#pragma unroll
              for (int q = 0; q < 2; ++q) { const int sj = sjb + q; f32x4 acc = (f32x4){0.f, 0.f, 0.f, 0.f};
                if (sj <= ti) {
#pragma unroll
                    for (int kk = 0; kk < 4; ++kk) { const bf16x8 av = *(const LAS bf16x8*)(Cs + (16 * ti + l15) * 136 + kk * 32 + quad * 8);
                        const bf16x8 bv = *(const LAS bf16x8*)(Bs + (16 * sj + l15) * 136 + kk * 32 + quad * 8); acc = MFMA16(av, bv, acc); }
                }
                const int s = 16 * sj + l15; const float acs_s = DTS[64 + s], dt_s = DTS[s];
#pragma unroll
                for (int r = 0; r < 4; ++r) { const int t = 16 * ti + 4 * quad + r; const float acs_t = DTS[64 + t];
                    const float v = (s <= t) ? acc[r] * __expf(acs_t - acs_s) * dt_s : 0.f; Lm[t * 72 + s] = f2bf(v); } } }
            __syncthreads();
            { const int ti = wid & 3, pj = wid >> 2; f32x4 accd = (f32x4){0.f, 0.f, 0.f, 0.f}, acco = (f32x4){0.f, 0.f, 0.f, 0.f};
#pragma unroll
              for (int kk = 0; kk < 2; ++kk) { const bf16x8 av = *(const LAS bf16x8*)(Lm + (16 * ti + l15) * 72 + kk * 32 + quad * 8);
                  const bf16x8 bv = *(const LAS bf16x8*)(xT + (16 * pj + l15) * 72 + kk * 32 + quad * 8); accd = MFMA16(av, bv, accd); }
#pragma unroll
              for (int kk = 0; kk < 4; ++kk) { const bf16x8 av = *(const LAS bf16x8*)(Cs + (16 * ti + l15) * 136 + kk * 32 + quad * 8);
                  const bf16x8 bv = *(const LAS bf16x8*)(St + (16 * pj + l15) * 136 + kk * 32 + quad * 8); acco = MFMA16(av, bv, acco); }
              const int p = 16 * pj + l15;
#pragma unroll
              for (int r = 0; r < 4; ++r) { const int t = 16 * ti + 4 * quad + r; const float y = accd[r] + DTS[128 + t] * acco[r] + Dh * xs[t * 33 + p];
                  A.Y[(size_t)(rowbase + t) * 1024 + h * 64 + ph * 32 + p] = f2bf(y); } }
            const int pi = wid & 1, njb = (wid >> 1) * 2; const float dec = __expf(acs63);
#pragma unroll
            for (int q = 0; q < 2; ++q) { const int nj = njb + q; f32x4 acc = (f32x4){0.f, 0.f, 0.f, 0.f};
#pragma unroll
                for (int kk = 0; kk < 2; ++kk) { const bf16x8 av = *(const LAS bf16x8*)(xwT + (16 * pi + l15) * 72 + kk * 32 + quad * 8);
                    const bf16x8 bv = *(const LAS bf16x8*)(BsT + (16 * nj + l15) * 72 + kk * 32 + quad * 8); acc = MFMA16(av, bv, acc); }
                state[q] = state[q] * dec + acc; }
            __syncthreads();
#pragma unroll
            for (int q = 0; q < 2; ++q)
#pragma unroll
                for (int r = 0; r < 4; ++r) St[(16 * pi + 4 * quad + r) * 136 + 16 * (njb + q) + l15] = f2bf(state[q][r]);
        }
    }
}

struct MixArgs { const bf16_t *Y, *Z, *UV, *SW; bf16_t* MIX; const float *norm_w, *ln_g, *ln_b, *sgu_b; };
__device__ __forceinline__ void mix_phase(LAS unsigned char* lds, const MixArgs& A, int G) {
    const int tid = threadIdx.x, lane = tid & 63, wid = __builtin_amdgcn_readfirstlane(tid >> 6), l15 = lane & 15, quad = lane >> 4;
    LAS float* stats = (LAS float*)lds;
    LAS bf16_t* VnT0 = (LAS bf16_t*)(lds + 1024);
    for (int u = blockIdx.x; u < M / 128; u += G) {
        const int m0 = u * 128;
        __syncthreads();
        for (int rr = wid; rr < 128; rr += NWAVES) {
            const size_t m = (size_t)(m0 + rr);
#pragma unroll
            for (int gi = 0; gi < 2; ++gi) {
                const int col = gi * 512 + lane * 8;
                const u32x4 yv = *(const u32x4*)(A.Y + m * 1024 + col), zv = *(const u32x4*)(A.Z + m * 1024 + col);
                float v[8]; float ss = 0.f;
#pragma unroll
                for (int e = 0; e < 4; ++e) { const float z0 = bflo(zv[e]), z1 = bfhi(zv[e]); v[2 * e] = bflo(yv[e]) * z0 * sigmoidf_(z0); v[2 * e + 1] = bfhi(yv[e]) * z1 * sigmoidf_(z1);
                    ss += v[2 * e] * v[2 * e] + v[2 * e + 1] * v[2 * e + 1]; }
                const float rs = 1.f / sqrtf(wave_sum(ss) * (1.f / 512.f) + LN_EPS);
                const f32x4 w0 = *(const f32x4*)(A.norm_w + col), w1 = *(const f32x4*)(A.norm_w + col + 4);
                u32x4 o; o.x = pk2(v[0] * rs * w0[0], v[1] * rs * w0[1]); o.y = pk2(v[2] * rs * w0[2], v[3] * rs * w0[3]);
                o.z = pk2(v[4] * rs * w1[0], v[5] * rs * w1[1]); o.w = pk2(v[6] * rs * w1[2], v[7] * rs * w1[3]);
                *(u32x4*)(A.MIX + m * 2048 + col) = o;
            }
            { const bf16_t* vr = A.UV + m * 2048 + 1024;
              const u32x4 a0 = *(const u32x4*)(vr + lane * 8), a1 = *(const u32x4*)(vr + 512 + lane * 8);
              float v[16]; float s = 0.f;
#pragma unroll
              for (int e = 0; e < 4; ++e) { v[2 * e] = bflo(a0[e]); v[2 * e + 1] = bfhi(a0[e]); v[8 + 2 * e] = bflo(a1[e]); v[8 + 2 * e + 1] = bfhi(a1[e]); }
#pragma unroll
              for (int e = 0; e < 16; ++e) s += v[e];
              const float mean = wave_sum(s) * (1.f / 1024.f); float s2 = 0.f;
#pragma unroll
              for (int e = 0; e < 16; ++e) { const float d = v[e] - mean; s2 += d * d; }
              const float rstd = 1.f / sqrtf(wave_sum(s2) * (1.f / 1024.f) + LN_EPS);
              if (lane == 0) { stats[2 * rr] = mean; stats[2 * rr + 1] = rstd; } }
        }
        __syncthreads();
        for (int gi = 0; gi < 8; ++gi) {
            LAS bf16_t* buf = VnT0 + (gi & 1) * (128 * 136);
#pragma unroll
            for (int i = 0; i < 4; ++i) { const int task = tid + NTHR * i, s = task & 127, cgp = task >> 7;
                const u32x4 vv = *(const u32x4*)(A.UV + (size_t)(m0 + s) * 2048 + 1024 + gi * 128 + cgp * 8);
                const float mean = stats[2 * s], rstd = stats[2 * s + 1];
                const f32x4 g0 = *(const f32x4*)(A.ln_g + gi * 128 + cgp * 8), g1 = *(const f32x4*)(A.ln_g + gi * 128 + cgp * 8 + 4);
                const f32x4 b0 = *(const f32x4*)(A.ln_b + gi * 128 + cgp * 8), b1 = *(const f32x4*)(A.ln_b + gi * 128 + cgp * 8 + 4);
#pragma unroll
                for (int e = 0; e < 4; ++e) { const float gA = e < 2 ? g0[2 * e] : g1[2 * e - 4], gB = e < 2 ? g0[2 * e + 1] : g1[2 * e - 3];
                    const float bA = e < 2 ? b0[2 * e] : b1[2 * e - 4], bB = e < 2 ? b0[2 * e + 1] : b1[2 * e - 3];
                    buf[(cgp * 8 + 2 * e) * 136 + s] = f2bf((bflo(vv[e]) - mean) * rstd * gA + bA);
                    buf[(cgp * 8 + 2 * e + 1) * 136 + s] = f2bf((bfhi(vv[e]) - mean) * rstd * gB + bB); } }
            __syncthreads();
            bf16x8 af[4];
#pragma unroll
            for (int kk = 0; kk < 4; ++kk) af[kk] = *(const bf16x8*)(A.SW + (size_t)gi * 16384 + (16 * wid + l15) * 128 + kk * 32 + quad * 8);
            float bias[4];
#pragma unroll
            for (int r = 0; r < 4; ++r) bias[r] = A.sgu_b[gi * 128 + 16 * wid + 4 * quad + r];
#pragma unroll 2
            for (int cj = 0; cj < 8; ++cj) { f32x4 acc = (f32x4){0.f, 0.f, 0.f, 0.f};
#pragma unroll
                for (int kk = 0; kk < 4; ++kk) { const bf16x8 bv = *(const LAS bf16x8*)(buf + (16 * cj + l15) * 136 + kk * 32 + quad * 8); acc = MFMA16(af[kk], bv, acc); }
#pragma unroll
                for (int r = 0; r < 4; ++r) { const size_t m = (size_t)(m0 + 16 * wid + 4 * quad + r); const int c = gi * 128 + 16 * cj + l15;
                    const float uval = bf2f(A.UV[m * 2048 + c]); A.MIX[m * 2048 + 1024 + c] = f2bf(uval * (acc[r] + bias[r])); } }
        }
    }
}

struct AttnArgs { const bf16_t *QK, *VT; bf16_t* AO; const float *lq1, *lk1, *lq2, *lk2, *subw; };
__device__ __forceinline__ int crow(int i, int hh) { return (i & 3) + 8 * (i >> 2) + 4 * hh; }
__device__ __forceinline__ void attn_tile(const LAS bf16_t* Kb, const LAS bf16_t* Vb, LAS float* wsf, const bf16x8 (&qf)[4], f32x16 (&O)[4], float& m_run, float& l_run,
                                          float slope2, int dpos  , bool diag, int map, int r, int hh) {
    f32x16 sv[2];
    float s2v = slope2; asm volatile("" : "+v"(s2v));
    const float dlane = (float)dpos;
    const float a_lane = -slope2 * dlane - m_run;
#pragma unroll
    for (int kb = 0; kb < 2; ++kb) {
#pragma unroll
        for (int i = 0; i < 16; ++i) sv[kb][i] = __builtin_fmaf(s2v, (float)(32 * kb + (i & 3) + 8 * (i >> 2)), a_lane);
#pragma unroll
        for (int s = 0; s < 4; ++s) { const bf16x8 av = *(const LAS bf16x8*)(Kb + (32 * kb + r) * 136 + map * 64 + 16 * s + 8 * hh); sv[kb] = MFMA32(av, qf[s], sv[kb]); }
    }
    if (diag) {
        const float s22 = 2.f * slope2;
#pragma unroll
        for (int kb = 0; kb < 2; ++kb)
#pragma unroll
            for (int i = 0; i < 16; ++i) sv[kb][i] = __builtin_fmaf(s22, fminf(dlane - (float)(32 * kb + (i & 3) + 8 * (i >> 2)), 0.f), sv[kb][i]);
    }
    float mx = -1e30f;
#pragma unroll
    for (int kb = 0; kb < 2; ++kb)
#pragma unroll
        for (int i = 0; i < 16; ++i) mx = fmaxf(mx, sv[kb][i]);
    mx = fmaxf(mx, __shfl_xor(mx, 32));
    if (diag || __any(mx > 6.0f)) {
        const float dl = diag ? mx : fmaxf(mx, 0.f); m_run += dl;
        const float alpha = __builtin_amdgcn_exp2f(-dl); l_run *= alpha;
        if (hh == 0) wsf[r] = alpha;
#pragma unroll
        for (int kb = 0; kb < 2; ++kb)
#pragma unroll
            for (int i = 0; i < 16; ++i) sv[kb][i] -= dl;
        if (!diag) {
#pragma unroll
            for (int i = 0; i < 16; ++i) { const float al = wsf[crow(i, hh)];
#pragma unroll
                for (int db = 0; db < 4; ++db) O[db][i] *= al; }
        }
    }
    float ps = 0.f;
#pragma unroll
    for (int kb = 0; kb < 2; ++kb)
#pragma unroll
        for (int i = 0; i < 16; ++i) { const float p = __builtin_amdgcn_exp2f(sv[kb][i]); sv[kb][i] = p; ps += p; }
    l_run += ps;
#pragma unroll
    for (int s2 = 0; s2 < 4; ++s2) { const int kb = s2 >> 1, hf = s2 & 1;
        u32x4 pw; pw.x = pk2(sv[kb][8 * hf + 0], sv[kb][8 * hf + 1]); pw.y = pk2(sv[kb][8 * hf + 2], sv[kb][8 * hf + 3]);
        pw.z = pk2(sv[kb][8 * hf + 4], sv[kb][8 * hf + 5]); pw.w = pk2(sv[kb][8 * hf + 6], sv[kb][8 * hf + 7]);
        const bf16x8 pa = __builtin_bit_cast(bf16x8, pw);
#pragma unroll
        for (int db = 0; db < 4; ++db) { const bf16x8 vf = *(const LAS bf16x8*)(Vb + (32 * db + r) * 72 + 32 * kb + 16 * hf + 8 * hh);
            O[db] = MFMA32(pa, vf, O[db]); } }
}
__device__ __forceinline__ void attn_phase(LAS unsigned char* lds, const AttnArgs& A, int G) {
    const int tid = threadIdx.x, lane = tid & 63, wid = __builtin_amdgcn_readfirstlane(tid >> 6), r = lane & 31, hh = lane >> 5;
    const int map = wid & 1, rg = wid >> 1;
    const float lam = __expf(wave_sum(A.lq1[lane] * A.lk1[lane])) - __expf(wave_sum(A.lq2[lane] * A.lk2[lane])) + LAMBDA_INIT;
    LAS bf16_t* Kbuf = (LAS bf16_t*)lds;
    LAS bf16_t* Vbuf = (LAS bf16_t*)(lds + 34816);
    LAS float* wsf = (LAS float*)(lds + 71680) + wid * 64;
    LAS float* XCH = (LAS float*)lds + rg * 4096;
    const int bx = (G % 8 == 0) ? (int)((blockIdx.x % 8) * (G / 8) + blockIdx.x / 8) : (int)blockIdx.x;
    for (int vb = bx; vb < 256; vb += G) {
        const int bh = vb >> 2, b = bh >> 3, h = bh & 7, sx = vb & 3;
        const float slope2 = exp2f(-(float)(h + 1)) * LOG2E;
        const int rowb = b * SEQ;
        for (int ui = 0; ui < 8; ++ui) {
            const int qb = (ui & 1) ? 8 * (ui >> 1) + 7 - sx : 8 * (ui >> 1) + sx;
            const int q0 = qb * 128, qc = 2 * qb + (rg >> 1), T0 = 2 * qb + 1;
            bf16x8 qf[4];
#pragma unroll
            for (int s = 0; s < 4; ++s) qf[s] = *(const bf16x8*)(A.QK + (size_t)(rowb + q0 + 32 * rg + r) * 2048 + h * 128 + map * 64 + 16 * s + 8 * hh);
            f32x16 O[4];
#pragma unroll
            for (int db = 0; db < 4; ++db)
#pragma unroll
                for (int i = 0; i < 16; ++i) O[db][i] = 0.f;
            float m_run = 0.f, l_run = 0.f;
            const int krow0 = tid >> 4, kcp = tid & 15, vd0 = tid >> 3, vcp = tid & 7;
            const bf16_t* ksrc = A.QK + (size_t)(rowb + krow0) * 2048 + 1024 + h * 128 + kcp * 8;
            const bf16_t* vsrc = A.VT + (size_t)(h * 128 + vd0) * M + rowb + vcp * 8;
            const int kdst = krow0 * 136 + kcp * 8, vdst = vd0 * 72 + 16 * (vcp >> 1) + 4 * (vcp & 1);
            u32x4 ka0, ka1, va0, va1, kb0, kb1, vb0, vb1;
#define ATT_LOAD(K0, K1, V0, V1, kt) do { K0 = *(const u32x4*)(ksrc + (size_t)((kt) * 64) * 2048); K1 = *(const u32x4*)(ksrc + (size_t)((kt) * 64 + 32) * 2048); \
                          V0 = *(const u32x4*)(vsrc + (kt) * 64); V1 = *(const u32x4*)(vsrc + (size_t)64 * M + (kt) * 64); } while (0)
#define ATT_WRITE(K0, K1, V0, V1, bufi) do { LAS bf16_t* kd_ = Kbuf + (bufi) * (64 * 136) + kdst; LAS bf16_t* vd_ = Vbuf + (bufi) * (128 * 72) + vdst; \
                          *(LAS u32x4*)(kd_) = K0; *(LAS u32x4*)(kd_ + 32 * 136) = K1; \
                          *(LAS u32x2*)(vd_) = (u32x2){V0.x, V0.y}; *(LAS u32x2*)(vd_ + 8) = (u32x2){V0.z, V0.w}; \
                          *(LAS u32x2*)(vd_ + 64 * 72) = (u32x2){V1.x, V1.y}; *(LAS u32x2*)(vd_ + 64 * 72 + 8) = (u32x2){V1.z, V1.w}; } while (0)
            __syncthreads();
            ATT_LOAD(ka0, ka1, va0, va1, T0); ATT_LOAD(kb0, kb1, vb0, vb1, T0 - 1);
            ATT_WRITE(ka0, ka1, va0, va1, 0);
            __syncthreads();
            const int dq = q0 + 32 * rg + r - 4 * hh;
            for (int kt = T0; kt >= 0; kt -= 2) {
                if (kt >= 2) ATT_LOAD(ka0, ka1, va0, va1, kt - 2);
                if (kt <= qc) attn_tile(Kbuf, Vbuf, wsf, qf, O, m_run, l_run, slope2, dq - kt * 64, kt == qc, map, r, hh);
                ATT_WRITE(kb0, kb1, vb0, vb1, 1);
                __syncthreads();
                if (kt >= 3) ATT_LOAD(kb0, kb1, vb0, vb1, kt - 3);
                attn_tile(Kbuf + 64 * 136, Vbuf + 128 * 72, wsf, qf, O, m_run, l_run, slope2, dq - (kt - 1) * 64, kt - 1 == qc, map, r, hh);
                if (kt >= 2) ATT_WRITE(ka0, ka1, va0, va1, 0);
                __syncthreads();
            }
#undef ATT_LOAD
#undef ATT_WRITE
            const float l_tot = l_run + __shfl_xor(l_run, 32);
            if (hh == 0) wsf[32 + r] = 1.f / l_tot;
#pragma unroll
            for (int i = 0; i < 16; ++i) { const float li = wsf[32 + crow(i, hh)];
#pragma unroll
                for (int db = 0; db < 4; ++db) O[db][i] *= li; }
            if (map == 1) {
#pragma unroll
                for (int db = 0; db < 4; ++db)
#pragma unroll
                    for (int i = 0; i < 16; ++i) XCH[(db * 16 + i) * 64 + lane] = O[db][i];
            }
            __syncthreads();
            if (map == 0) {
                float ss[16];
#pragma unroll
                for (int i = 0; i < 16; ++i) { float a = 0.f;
#pragma unroll
                    for (int db = 0; db < 4; ++db) { const float o = O[db][i] - lam * XCH[(db * 16 + i) * 64 + lane]; O[db][i] = o; a += o * o; }
                    ss[i] = a; }
#pragma unroll
                for (int i = 0; i < 16; ++i) {
#pragma unroll
                    for (int o = 1; o < 32; o <<= 1) ss[i] += __shfl_xor(ss[i], o);
                    ss[i] = (1.f - LAMBDA_INIT) / sqrtf(ss[i] * (1.f / 128.f) + LN_EPS); }
#pragma unroll
                for (int db = 0; db < 4; ++db) { const float w = A.subw[32 * db + r];
#pragma unroll
                    for (int i = 0; i < 16; ++i) A.AO[(size_t)(rowb + q0 + 32 * rg + crow(i, hh)) * 1024 + h * 128 + 32 * db + r] = f2bf(O[db][i] * ss[i] * w); }
            }
        }
    }
}

struct Args { const float* in[26]; float* out; unsigned char* ws; int ph_lo, ph_hi; };
__global__ void __launch_bounds__(NTHR, 2) mega_fwd(Args args) {
    extern __shared__ __attribute__((aligned(16))) unsigned char lds_raw[];
    LAS unsigned char* lds = (LAS unsigned char*)lds_raw;
    cg::grid_group grid = cg::this_grid();
    const int G = gridDim.x;
    unsigned char* ws = args.ws;
    float* out = args.out;
    bf16_t* XB = (bf16_t*)(ws + WS_XB);
    bf16_t* MIX = (bf16_t*)(ws + WS_BIG);
    bf16_t* UV = (bf16_t*)(ws + WS_BIG + 128 * MiB);
    bf16_t* FF = (bf16_t*)(ws + WS_BIG);
    bf16_t* QK = (bf16_t*)(ws + WS_BIG);
    bf16_t* VT = (bf16_t*)(ws + WS_BIG + 128 * MiB);
    bf16_t* AO = (bf16_t*)(ws + WS_BIG + 192 * MiB);
    bf16_t* XBC = (bf16_t*)(ws + WS_XBC);
    float* DT = (float*)(ws + WS_DT);
    bf16_t* Zb = (bf16_t*)out;
    bf16_t* Yb = (bf16_t*)out + (size_t)M * 1024;
    const int lo = args.ph_lo, hi = args.ph_hi;
    if (threadIdx.x < 4) ((LAS unsigned*)(lds + LDS_BYTES - 16))[threadIdx.x] = 0u;
    __syncthreads();
    const XcdBarrier xbar = xcd_barrier_post((unsigned*)ws, (volatile LAS unsigned*)(lds + LDS_BYTES - 16));
#ifndef ONLY
#define EN(k) 1
#else
#define EN(k) ((ONLY)==(k))
#endif
#define IN(k) (EN(k) && lo <= (k) && (k) < hi)
#define SEAM(k) do { if ((k) + 1 < hi) { for (int rs_ = 0; rs_ < REP_SYNC; ++rs_) { if ((k) == 0) grid.sync(); else xcd_barrier(xbar); } } } while (0)
#define GEMM_RES(k, Aop, Wt, Kdim, rbase) if (IN(k)) { pg8::Gemm g{(Aop), (const bf16_t*)(ws + (Wt)), M, 1024, (Kdim)}; pg8::StaticOrder S; S.init(M, 1024, G, (int)blockIdx.x); \
        pg8::EpiRes E{(rbase), out, ALPHA}; pg8::gemm_phase<pg8::EpiRes, pg8::StaticOrder, true, true>(lds, g, S, E); SEAM(k); }
#define GEMM_UP(k, Wt) if (IN(k)) { pg8::Gemm g{XB, (const bf16_t*)(ws + (Wt)), M, 4096, 1024}; pg8::StaticOrder S; S.init(M, 4096, G, (int)blockIdx.x); \
        pg8::EpiPlain<2> E{FF, 4096}; pg8::gemm_phase<pg8::EpiPlain<2>, pg8::StaticOrder, true, true>(lds, g, S, E); SEAM(k); }
#define LNPH(k, gi, bi, l) if (IN(k)) { ln_phase(out, XB, args.in[gi] + (l) * 1024, args.in[bi] + (l) * 1024, G); SEAM(k); }
    if (IN(0)) { P0Args a{args.in[0], args.in[1], args.in[12], args.in[24], args.in[25], args.in[13], args.in[19], args.in[10], ws}; for (int rep = 0; rep < REP_P0; ++rep) p0_prologue(lds, a, G); SEAM(0); }
    if (IN(1)) { pg8::Gemm g{XB, (const bf16_t*)(ws + WS_WIN), M, 4864, 1024}; pg8::StaticOrder S; S.init(M, 4864, G, (int)blockIdx.x);
                 pg8::EpiInProj E{Zb, XBC, UV, DT}; pg8::gemm_phase<pg8::EpiInProj, pg8::StaticOrder, true, true>(lds, g, S, E); SEAM(1); }
    if (IN(2)) { SsdArgs a{XBC, DT, Yb, args.in[2], args.in[3], args.in[4], args.in[5], args.in[6]}; for (int rep = 0; rep < REP_SSD; ++rep) ssd_phase(lds, a, G); SEAM(2); }
    if (IN(3)) { MixArgs a{Yb, Zb, UV, (const bf16_t*)(ws + WS_SGUW), MIX, args.in[7], args.in[8], args.in[9], args.in[11]}; for (int rep = 0; rep < REP_MIX; ++rep) mix_phase(lds, a, G); SEAM(3); }
    GEMM_RES(4, MIX, WS_WOUT0, 2048, args.in[0])
    LNPH(5, 20, 21, 0)
    GEMM_UP(6, WS_WUP0)
    GEMM_RES(7, FF, WS_WDN0, 4096, out)
    LNPH(8, 22, 23, 0)
    if (IN(9)) { pg8::Gemm g{XB, (const bf16_t*)(ws + WS_WQK), M, 2048, 1024}; pg8::StaticOrder S; S.init(M, 2048, G, (int)blockIdx.x);
                 pg8::EpiPlain<0> E{QK, 2048}; pg8::gemm_phase<pg8::EpiPlain<0>, pg8::StaticOrder, true, true>(lds, g, S, E); SEAM(9); }
    if (IN(10)) { pg8::Gemm g{(const bf16_t*)(ws + WS_WV), XB, 1024, M, 1024}; pg8::StaticOrder S; S.init(1024, M, G, (int)blockIdx.x);
                 pg8::EpiPlain<0> E{VT, M}; pg8::gemm_phase<pg8::EpiPlain<0>, pg8::StaticOrder, true, true>(lds, g, S, E); SEAM(10); }
    if (IN(11)) { AttnArgs a{QK, VT, AO, args.in[14], args.in[15], args.in[16], args.in[17], args.in[18]}; for (int rep = 0; rep < REP_ATTN; ++rep) attn_phase(lds, a, G); SEAM(11); }
    GEMM_RES(12, AO, WS_WO1, 1024, out)
    LNPH(13, 20, 21, 1)
    GEMM_UP(14, WS_WUP1)
    GEMM_RES(15, FF, WS_WDN1, 4096, out)
    LNPH(16, 22, 23, 1)
}

extern "C" void kernel_launch(void* const* d_in, const int* in_sizes, int n_in, void* d_out, int out_size, void* d_ws, size_t ws_size, hipStream_t stream) {
    static int grid = 0;
    if (grid == 0) {
        if (n_in != 26 || out_size != M * DM || ws_size < WS_END) { fprintf(stderr, "kernel_launch: unexpected shapes (n_in %d out %d ws %zu)\n", n_in, out_size, ws_size); grid = -1; return; }
        int dev = 0, cus = 0, per_cu = 0;
        hipGetDevice(&dev); hipDeviceGetAttribute(&cus, hipDeviceAttributeMultiprocessorCount, dev);
        if (hipFuncSetAttribute((const void*)mega_fwd, hipFuncAttributeMaxDynamicSharedMemorySize, LDS_BYTES) != hipSuccess) { fprintf(stderr, "kernel_launch: hipFuncSetAttribute failed\n"); grid = -1; return; }
        if (hipOccupancyMaxActiveBlocksPerMultiprocessor(&per_cu, (const void*)mega_fwd, NTHR, LDS_BYTES) != hipSuccess || per_cu < 1) { fprintf(stderr, "kernel_launch: occupancy query gives %d\n", per_cu); per_cu = 1; }
        (void)hipGetLastError();
        grid = cus * (per_cu > 1 ? 1 : per_cu);
        if (grid <= 0) grid = 256;
    }
    if (grid < 0) return;
    Args a{};
    for (int i = 0; i < 26; ++i) a.in[i] = (const float*)d_in[i];
    a.out = (float*)d_out; a.ws = (unsigned char*)d_ws; a.ph_lo = 0; a.ph_hi = NPHASE;
    if (hipMemsetAsync(d_ws, 0, 16384, stream) != hipSuccess) { fprintf(stderr, "kernel_launch: memset failed\n"); return; }
    void* kargs[] = {&a};
    hipError_t e = hipLaunchCooperativeKernel((const void*)mega_fwd, dim3(grid), dim3(NTHR), kargs, LDS_BYTES, stream);
    if (e != hipSuccess) fprintf(stderr, "kernel_launch: cooperative launch failed: %s (grid %d)\n", hipGetErrorString(e), grid);
}
```
